# Optimizing an MI355X kernel written in HIP

```python
import jax, jax.numpy as jnp
from jax import lax
import numpy as np

D_MODEL = 1024
BATCH = 4
SEQ = 4096
DEPTH = 2

MEM_LEN = 256
GRID_W = 64
Q_BLOCK = 128
EPS = 1e-6

ATTN_HEADS = 8
ATTN_KV_HEADS = 2
HEAD_DIM = 64
ATTN_Q_W = ATTN_HEADS * HEAD_DIM
ATTN_KV_W = ATTN_KV_HEADS * HEAD_DIM
ROPE_THETA = 10000.0

GMLP_W = 512
GMLP_GROUPS = 4
GMLP_GROUP_W = GMLP_W // GMLP_GROUPS
GMLP_CHUNK = 128

LRU_W = 512
LRU_HEADS = 8
LRU_HEAD_W = LRU_W // LRU_HEADS
CONV_W = 4
LRU_C = 8.0
N_DIR = 2

N_BRANCH = 3

XATTN_HEADS = 4
XATTN_HEAD_DIM = D_MODEL // XATTN_HEADS

D_FF = 2816

MIX_IN_W = ATTN_Q_W + 2 * ATTN_KV_W + 2 * GMLP_W + 2 * LRU_W + N_BRANCH * D_MODEL
MIX_IN_SPLITS = (
    ATTN_Q_W,
    ATTN_Q_W + ATTN_KV_W,
    ATTN_Q_W + 2 * ATTN_KV_W,
    ATTN_Q_W + 2 * ATTN_KV_W + GMLP_W,
    ATTN_Q_W + 2 * ATTN_KV_W + 2 * GMLP_W,
    ATTN_Q_W + 2 * ATTN_KV_W + 2 * GMLP_W + LRU_W,
    ATTN_Q_W + 2 * ATTN_KV_W + 2 * GMLP_W + 2 * LRU_W,
)

kernel_name = "hybrid_gated_parallel_encoder"


def rms_norm(x, g):
    xf = x.astype(jnp.float32)
    y = xf * lax.rsqrt(jnp.mean(xf * xf, axis=-1, keepdims=True) + EPS)
    return (y * g.astype(jnp.float32)).astype(x.dtype)


def swiglu(h, w_in, w_out):
    a, b = jnp.split(h @ w_in, 2, axis=-1)
    return (jax.nn.silu(a) * b) @ w_out


def axial_rope_tables(seq_len):
    rows = seq_len // GRID_W
    row = jnp.repeat(jnp.arange(rows), GRID_W).astype(jnp.float32)
    col = jnp.tile(jnp.arange(GRID_W), rows).astype(jnp.float32)
    n_freq = HEAD_DIM // 4
    inv_freq = ROPE_THETA ** (-jnp.arange(n_freq, dtype=jnp.float32) / n_freq)
    ang_r = row[:, None] * inv_freq[None, :]
    ang_c = col[:, None] * inv_freq[None, :]
    return (jnp.cos(ang_r), jnp.sin(ang_r), jnp.cos(ang_c), jnp.sin(ang_c))


def _rotate(x, cos, sin):
    x1, x2 = jnp.split(x, 2, axis=-1)
    c = cos[:, None, :]
    s = sin[:, None, :]
    return jnp.concatenate([x1 * c - x2 * s, x2 * c + x1 * s], axis=-1)


def apply_axial_rope(x, tabs):
    cos_r, sin_r, cos_c, sin_c = tabs
    xf = x.astype(jnp.float32)
    x_row, x_col = jnp.split(xf, 2, axis=-1)
    out = jnp.concatenate([_rotate(x_row, cos_r, sin_r), _rotate(x_col, cos_c, sin_c)], axis=-1)
    return out.astype(x.dtype)


def gqa_block_attention(q, k, v):
    b, s, _, _ = q.shape
    nb = s // Q_BLOCK
    grp = ATTN_HEADS // ATTN_KV_HEADS
    qb = q.reshape(b, nb, Q_BLOCK, ATTN_KV_HEADS, grp, HEAD_DIM).transpose(1, 0, 2, 3, 4, 5)
    scale = HEAD_DIM ** -0.5

    def one_block(qi):
        sc = jnp.einsum('bqkgd,bskd->bkgqs', qi, k).astype(jnp.float32) * scale
        p = jax.nn.softmax(sc, axis=-1).astype(v.dtype)
        return jnp.einsum('bkgqs,bskd->bqkgd', p, v)

    o = lax.map(one_block, qb)
    return o.transpose(1, 0, 2, 3, 4, 5).reshape(b, s, ATTN_Q_W)


def gmlp_branch(u, v, v_norm, ws, bs):
    b, s, _ = u.shape
    nc = s // GMLP_CHUNK
    u = jax.nn.gelu(u)
    v = rms_norm(jax.nn.gelu(v), v_norm)
    vc = v.reshape(b, nc, GMLP_CHUNK, GMLP_GROUPS, GMLP_GROUP_W)
    sv = jnp.einsum('gpq,bcqgd->bcpgd', ws, vc) + bs.T[:, :, None]
    return u * sv.reshape(b, s, GMLP_W)


def depthwise_conv_centred(x, w, bias):
    out = lax.conv_general_dilated(
        x, w[:, None, :], window_strides=(1,),
        padding=[(CONV_W // 2, CONV_W - 1 - CONV_W // 2)],
        dimension_numbers=('NWC', 'WIO', 'NWC'),
        feature_group_count=x.shape[-1])
    return out + bias


def block_diag(x, w, bias):
    b, s, _ = x.shape
    y = jnp.einsum('bshi,hio->bsho', x.reshape(b, s, LRU_HEADS, LRU_HEAD_W), w)
    return y.reshape(b, s, LRU_W) + bias


def rg_lru(x, wa, ba, wi, bi, lam, reverse):
    r = jax.nn.sigmoid(block_diag(x, wa, ba).astype(jnp.float32))
    i = jax.nn.sigmoid(block_diag(x, wi, bi).astype(jnp.float32))
    log_a = -LRU_C * r * jax.nn.softplus(-lam.astype(jnp.float32))
    a = jnp.exp(log_a)
    bx = jnp.sqrt(-jnp.expm1(2.0 * log_a)) * (i * x.astype(jnp.float32))

    def combine(e1, e2):
        a1, b1 = e1
        a2, b2 = e2
        return a1 * a2, a2 * b1 + b2

    _, h = lax.associative_scan(combine, (a, bx), axis=1, reverse=reverse)
    return h.astype(x.dtype)


def lru_branch(xl, yl, conv_w, conv_b, wa, ba, wi, bi, lam):
    xc = depthwise_conv_centred(xl, conv_w, conv_b)
    h = (rg_lru(xc, wa[0], ba[0], wi[0], bi[0], lam[0], False)
         + rg_lru(xc, wa[1], ba[1], wi[1], bi[1], lam[1], True))
    return h * jax.nn.gelu(yl)


def cross_attention(h, mem_n, wq, wkv, wo):
    b, s, _ = h.shape
    m = mem_n.shape[1]
    q = (h @ wq).reshape(b, s, XATTN_HEADS, XATTN_HEAD_DIM)
    k, v = jnp.split(mem_n @ wkv, 2, axis=-1)
    k = k.reshape(b, m, XATTN_HEADS, XATTN_HEAD_DIM)
    v = v.reshape(b, m, XATTN_HEADS, XATTN_HEAD_DIM)
    sc = jnp.einsum('bqhd,bmhd->bhqm', q, k).astype(jnp.float32) * (XATTN_HEAD_DIM ** -0.5)
    p = jax.nn.softmax(sc, axis=-1).astype(v.dtype)
    o = jnp.einsum('bhqm,bmhd->bqhd', p, v).reshape(b, s, D_MODEL)
    return o @ wo


def setup_inputs(seed: int = 0) -> dict:
    key = jax.random.key(seed)
    ks = iter(jax.random.split(key, 40))
    L = DEPTH

    def nrm(shape, scale):
        return jax.random.normal(next(ks), shape, jnp.float32) * scale

    def gain(shape):
        return 1.0 + nrm(shape, 0.01)

    x = nrm((BATCH, SEQ, D_MODEL), 1.0)
    mem = nrm((BATCH, MEM_LEN, D_MODEL), 1.0)
    ffn1_norm = gain((L, D_MODEL))
    ffn1_w_in = nrm((L, D_MODEL, 2 * D_FF), D_MODEL ** -0.5)
    ffn1_w_out = nrm((L, D_FF, D_MODEL), D_FF ** -0.5)
    mix_norm = gain((L, D_MODEL))
    w_mix_in = nrm((L, D_MODEL, MIX_IN_W), D_MODEL ** -0.5)
    b_gate = nrm((L, N_BRANCH * D_MODEL), 0.01)
    q_norm = gain((L, HEAD_DIM))
    k_norm = gain((L, HEAD_DIM))
    attn_up = nrm((L, ATTN_Q_W, D_MODEL), ATTN_Q_W ** -0.5)
    gmlp_v_norm = gain((L, GMLP_W))
    gmlp_ws = nrm((L, GMLP_GROUPS, GMLP_CHUNK, GMLP_CHUNK), 0.5 * GMLP_CHUNK ** -0.5)
    gmlp_bs = gain((L, GMLP_GROUPS, GMLP_CHUNK))
    gmlp_up = nrm((L, GMLP_W, D_MODEL), GMLP_W ** -0.5)
    lru_conv_w = nrm((L, CONV_W, LRU_W), CONV_W ** -0.5)
    lru_conv_b = nrm((L, LRU_W), 0.01)
    lru_wa = nrm((L, N_DIR, LRU_HEADS, LRU_HEAD_W, LRU_HEAD_W), LRU_HEAD_W ** -0.5)
    lru_ba = nrm((L, N_DIR, LRU_W), 0.01)
    lru_wi = nrm((L, N_DIR, LRU_HEADS, LRU_HEAD_W, LRU_HEAD_W), LRU_HEAD_W ** -0.5)
    lru_bi = nrm((L, N_DIR, LRU_W), 0.01)
    a_pow_c = jax.random.uniform(next(ks), (L, N_DIR, LRU_W), jnp.float32, 0.9, 0.999)
    a0 = a_pow_c ** (1.0 / LRU_C)
    lru_lambda = jnp.log(a0) - jnp.log1p(-a0)
    lru_up = nrm((L, LRU_W, D_MODEL), LRU_W ** -0.5)
    w_mix_out = nrm((L, D_MODEL, D_MODEL), D_MODEL ** -0.5)
    xattn_norm = gain((L, D_MODEL))
    mem_norm = gain((L, D_MODEL))
    xattn_wq = nrm((L, D_MODEL, D_MODEL), D_MODEL ** -0.5)
    xattn_wkv = nrm((L, D_MODEL, 2 * D_MODEL), D_MODEL ** -0.5)
    xattn_wo = nrm((L, D_MODEL, D_MODEL), D_MODEL ** -0.5)
    ffn2_norm = gain((L, D_MODEL))
    ffn2_w_in = nrm((L, D_MODEL, 2 * D_FF), D_MODEL ** -0.5)
    ffn2_w_out = nrm((L, D_FF, D_MODEL), D_FF ** -0.5)
    final_norm = gain((D_MODEL,))
    return {
        "x": x, "mem": mem,
        "ffn1_norm": ffn1_norm, "ffn1_w_in": ffn1_w_in, "ffn1_w_out": ffn1_w_out,
        "mix_norm": mix_norm, "w_mix_in": w_mix_in, "b_gate": b_gate,
        "q_norm": q_norm, "k_norm": k_norm, "attn_up": attn_up,
        "gmlp_v_norm": gmlp_v_norm, "gmlp_ws": gmlp_ws, "gmlp_bs": gmlp_bs, "gmlp_up": gmlp_up,
        "lru_conv_w": lru_conv_w, "lru_conv_b": lru_conv_b,
        "lru_wa": lru_wa, "lru_ba": lru_ba, "lru_wi": lru_wi, "lru_bi": lru_bi,
        "lru_lambda": lru_lambda, "lru_up": lru_up,
        "w_mix_out": w_mix_out,
        "xattn_norm": xattn_norm, "mem_norm": mem_norm,
        "xattn_wq": xattn_wq, "xattn_wkv": xattn_wkv, "xattn_wo": xattn_wo,
        "ffn2_norm": ffn2_norm, "ffn2_w_in": ffn2_w_in, "ffn2_w_out": ffn2_w_out,
        "final_norm": final_norm,
    }


def reference(x, mem, ffn1_norm, ffn1_w_in, ffn1_w_out, mix_norm, w_mix_in, b_gate,
              q_norm, k_norm, attn_up, gmlp_v_norm, gmlp_ws, gmlp_bs, gmlp_up,
              lru_conv_w, lru_conv_b, lru_wa, lru_ba, lru_wi, lru_bi, lru_lambda, lru_up,
              w_mix_out, xattn_norm, mem_norm, xattn_wq, xattn_wkv, xattn_wo,
              ffn2_norm, ffn2_w_in, ffn2_w_out, final_norm):
    b, s, _ = x.shape
    tabs = axial_rope_tables(s)
    for l in range(DEPTH):
        x = x + 0.5 * swiglu(rms_norm(x, ffn1_norm[l]), ffn1_w_in[l], ffn1_w_out[l])

        h = rms_norm(x, mix_norm[l])
        q, k, v, gu, gv, lx, ly, g = jnp.split(h @ w_mix_in[l], MIX_IN_SPLITS, axis=-1)

        q = apply_axial_rope(rms_norm(q.reshape(b, s, ATTN_HEADS, HEAD_DIM), q_norm[l]), tabs)
        k = apply_axial_rope(rms_norm(k.reshape(b, s, ATTN_KV_HEADS, HEAD_DIM), k_norm[l]), tabs)
        v = v.reshape(b, s, ATTN_KV_HEADS, HEAD_DIM)
        y_attn = gqa_block_attention(q, k, v) @ attn_up[l]

        y_gmlp = gmlp_branch(gu, gv, gmlp_v_norm[l], gmlp_ws[l], gmlp_bs[l]) @ gmlp_up[l]

        y_lru = lru_branch(lx, ly, lru_conv_w[l], lru_conv_b[l], lru_wa[l], lru_ba[l],
                           lru_wi[l], lru_bi[l], lru_lambda[l]) @ lru_up[l]

        gates = jax.nn.sigmoid((g + b_gate[l]).astype(jnp.float32)).astype(x.dtype)
        gates = gates.reshape(b, s, N_BRANCH, D_MODEL)
        merged = gates[:, :, 0] * y_attn + gates[:, :, 1] * y_gmlp + gates[:, :, 2] * y_lru
        x = x + merged @ w_mix_out[l]

        x = x + cross_attention(rms_norm(x, xattn_norm[l]), rms_norm(mem, mem_norm[l]),
                                xattn_wq[l], xattn_wkv[l], xattn_wo[l])

        x = x + 0.5 * swiglu(rms_norm(x, ffn2_norm[l]), ffn2_w_in[l], ffn2_w_out[l])
    return rms_norm(x, final_norm)
```

```cpp
#include <hip/hip_runtime.h>
#include <hip/hip_cooperative_groups.h>
#include <cstdio>
namespace cg = cooperative_groups;

typedef unsigned short bf16_t;
typedef short bf16x8 __attribute__((ext_vector_type(8)));
typedef float f32x4 __attribute__((ext_vector_type(4)));
#define DEVI __device__ __forceinline__
#define LDS_AS __attribute__((address_space(3)))
DEVI int TID512() { int t = threadIdx.x; asm volatile("" : "+v"(t)); return t; }
DEVI int TIDX() { int t = threadIdx.x & 255; asm volatile("" : "+v"(t)); return t; }

constexpr int M = 16384, DM = 1024, FF = 2816;
constexpr float EPS = 1e-6f;
constexpr int NPH = 27;

constexpr size_t W_1IN = 0;
constexpr size_t W_1OUT = W_1IN + (size_t)5632 * 1024;
constexpr size_t W_MIX = W_1OUT + (size_t)1024 * 2816;
constexpr size_t W_AU = W_MIX + (size_t)5888 * 1024;
constexpr size_t W_GU = W_AU + (size_t)1024 * 512;
constexpr size_t W_LU = W_GU + (size_t)1024 * 512;
constexpr size_t W_MO = W_LU + (size_t)1024 * 512;
constexpr size_t W_Q = W_MO + (size_t)1024 * 1024;
constexpr size_t W_KV = W_Q + (size_t)1024 * 1024;
constexpr size_t W_O = W_KV + (size_t)2048 * 1024;
constexpr size_t W_2IN = W_O + (size_t)1024 * 1024;
constexpr size_t W_2OUT = W_2IN + (size_t)5632 * 1024;
constexpr size_t W_LWA = W_2OUT + (size_t)1024 * 2816;
constexpr size_t W_LWI = W_LWA + 65536;
constexpr size_t W_GWS = W_LWI + 65536;
constexpr size_t W_END = W_GWS + 65536;
constexpr size_t O_W = 0;
constexpr size_t O_XB = O_W + W_END * 2;
constexpr size_t O_R1 = O_XB + (size_t)M * DM * 2;
constexpr size_t O_H = O_R1;
constexpr size_t O_Q = O_R1;
constexpr size_t O_KB = O_Q + (size_t)M * 512 * 2;
constexpr size_t O_VT = O_KB + (size_t)M * 128 * 2;
constexpr size_t O_GU = O_VT + (size_t)M * 128 * 2;
constexpr size_t O_GVT = O_GU + (size_t)M * 512 * 2;
constexpr size_t O_LX = O_GVT + (size_t)M * 512 * 2;
constexpr size_t O_GY = O_LX + (size_t)M * 512 * 2;
constexpr size_t O_MERGED = O_GVT;
constexpr size_t O_R2 = O_R1 + (size_t)M * FF * 2;
constexpr size_t O_GATES = O_R2;
constexpr size_t O_QX = O_R2;
constexpr size_t O_OX = O_R2 + (size_t)M * DM * 2;
constexpr size_t O_MEMN = O_R2 + (size_t)M * DM * 4;
constexpr size_t O_KX = O_R2 + (size_t)M * 3072 * 2;
constexpr size_t O_VXT = O_KX + (size_t)1024 * 1024 * 2;
constexpr size_t O_AGG = O_VXT + (size_t)1024 * 1024 * 2;
constexpr size_t O_SS = O_AGG + (size_t)4 * 2 * 64 * 512 * 8;
constexpr size_t O_ROPE = O_SS + (size_t)11 * 16 * M * 4;
constexpr size_t O_BAR = O_ROPE + 8192;
constexpr size_t O_SP = O_BAR + 16384;
constexpr size_t O_END = O_SP + 4096;
static_assert(O_GY + (size_t)M * 512 * 2 == O_R2, "R1 mixer set must equal H");

struct Params { const float* in[33]; float* out; unsigned char* ws; int lo, hi; };
__device__ __forceinline__ const float* IN(const Params& p, int i) { const float* q = p.in[i]; asm volatile("" : "+s"(q)); return q; }
__device__ __forceinline__ unsigned char* WS(const Params& p) { unsigned char* w = p.ws; asm volatile("" : "+s"(w)); return w; }

DEVI unsigned f2bf(float f) { unsigned u = __float_as_uint(f); return (u + 0x7fffu + ((u >> 16) & 1u)) >> 16; }
DEVI float bf2f(unsigned h) { return __uint_as_float(h << 16); }
DEVI unsigned pk2(float a, float b) { unsigned r; asm("v_cvt_pk_bf16_f32 %0, %1, %2" : "=v"(r) : "v"(a), "v"(b)); return r; }
DEVI uint2 pk4(f32x4 v) { return make_uint2(pk2(v[0], v[1]), pk2(v[2], v[3])); }
DEVI f32x4 unpk4(uint2 u) { f32x4 r; r[0] = bf2f(u.x & 0xffffu); r[1] = bf2f(u.x >> 16); r[2] = bf2f(u.y & 0xffffu); r[3] = bf2f(u.y >> 16); return r; }
DEVI float sigm(float x) { return __builtin_amdgcn_rcpf(1.f + __expf(-x)); }
DEVI float gelu_t(float x) { float u = 0.7978845608028654f * (x + 0.044715f * x * x * x); return x * sigm(2.f * u); }
DEVI float wave_sum(float v) { for (int o = 32; o > 0; o >>= 1) v += __shfl_xor(v, o); return v; }
DEVI float* SSP(const Params& p, int slot) { return (float*)(WS(p) + O_SS) + (size_t)slot * 16 * M; }
template <int NP> DEVI float ss_sum(const float* ss, int row) { float s = 0.f;
#pragma unroll
    for (int i = 0; i < NP; ++i) s += ss[(size_t)i * M + row];
    return s; }

#define LANE512 const int tid5 = TID512(); const int lane = tid5 & 63, wave = tid5 >> 6, wr = wave >> 2, wc = wave & 3, l15 = lane & 15, quad = lane >> 4; (void)wr; (void)wc; (void)l15; (void)quad; (void)wave;
#define LANE_VARS const int tid_ = TIDX(); const int lane = tid_ & 63, wave = tid_ >> 6, wr = wave >> 1, wc = wave & 1, l15 = lane & 15, quad = lane >> 4; (void)wr; (void)wc; (void)l15; (void)quad; (void)wave;

template <int RB> DEVI int swz(int row, int c) {
    if (RB == 128) return row * 128 + ((c ^ ((row >> 1) & 7)) << 4);
    if (RB == 512) return row * 512 + ((c ^ (row & 15)) << 4);
    return row * 64 + ((c ^ ((row >> 2) & 3)) << 4);
}

template <int NTW>
DEVI void compute_ktile(const char* la, const char* lb, f32x4 (&acc)[4][NTW], int aoff0, int aoff1, int boff0, int boff1) {
#pragma unroll
    for (int ks = 0; ks < 2; ++ks) {
        bf16x8 af[4], bfr[NTW];
        const int ao = ks ? aoff1 : aoff0, bo = ks ? boff1 : boff0;
#pragma unroll
        for (int mt = 0; mt < 4; ++mt) af[mt] = *(const bf16x8*)(la + ao + mt * 2048);
#pragma unroll
        for (int nt = 0; nt < NTW; ++nt) bfr[nt] = *(const bf16x8*)(lb + bo + nt * 2048);
#pragma unroll
        for (int mt = 0; mt < 4; ++mt)
#pragma unroll
            for (int nt = 0; nt < NTW; ++nt) acc[mt][nt] = __builtin_amdgcn_mfma_f32_16x16x32_bf16(bfr[nt], af[mt], acc[mt][nt], 0, 0, 0);
    }
}
#define KT_OFFS(NTW) const int aoff0 = swz<128>(wr * 64 + l15, quad), aoff1 = swz<128>(wr * 64 + l15, 4 + quad), boff0 = swz<128>(wc * (NTW * 16) + l15, quad), boff1 = swz<128>(wc * (NTW * 16) + l15, 4 + quad);

template <int NTW>
DEVI void gemm_kloop(const bf16_t* __restrict__ A, int lda, const bf16_t* __restrict__ B, int ldb, int K, char* lds, f32x4 (&acc)[4][NTW]) {
    LANE_VARS
    KT_OFFS(NTW)
    const int tid = tid_;
    const int srow = tid >> 3, sc = tid & 7;
    const bf16_t* ga = A + (size_t)srow * lda + sc * 8;
    const bf16_t* gb = B + (size_t)srow * ldb + sc * 8;
    const int soff = swz<128>(srow, sc);
    uint4 ra0, ra1, ra2, ra3, rb0, rb1, rb2, rb3;
    rb2 = rb3 = make_uint4(0, 0, 0, 0);
    const int nk = K >> 6;
#define G_LOAD(k0) { ra0 = *(const uint4*)(ga + (k0)); ra1 = *(const uint4*)(ga + (size_t)32 * lda + (k0)); ra2 = *(const uint4*)(ga + (size_t)64 * lda + (k0)); ra3 = *(const uint4*)(ga + (size_t)96 * lda + (k0)); \
        rb0 = *(const uint4*)(gb + (k0)); rb1 = *(const uint4*)(gb + (size_t)32 * ldb + (k0)); \
        if (NTW == 4) { rb2 = *(const uint4*)(gb + (size_t)64 * ldb + (k0)); rb3 = *(const uint4*)(gb + (size_t)96 * ldb + (k0)); } }
#define G_STORE(ls) { *(uint4*)((ls) + soff) = ra0; *(uint4*)((ls) + soff + 4096) = ra1; *(uint4*)((ls) + soff + 8192) = ra2; *(uint4*)((ls) + soff + 12288) = ra3; \
        *(uint4*)((ls) + 16384 + soff) = rb0; *(uint4*)((ls) + 16384 + soff + 4096) = rb1; \
        if (NTW == 4) { *(uint4*)((ls) + 16384 + soff + 8192) = rb2; *(uint4*)((ls) + 16384 + soff + 12288) = rb3; } }
    G_LOAD(0)
    __syncthreads();
    G_STORE(lds)
    __syncthreads();
    for (int kt = 0; kt < nk; ++kt) {
        const bool more = (kt + 1 < nk);
        if (more) { const int k0 = (kt + 1) << 6; G_LOAD(k0) }
        const char* la = lds + (kt & 1) * 32768;
        compute_ktile<NTW>(la, la + 16384, acc, aoff0, aoff1, boff0, boff1);
        if (more) { char* ls = lds + ((kt + 1) & 1) * 32768; G_STORE(ls) }
        __syncthreads();
    }
#undef G_LOAD
#undef G_STORE
}

template <int NTW>
DEVI void compute_tile8(const char* la, const char* lb, f32x4 (&acc)[8][NTW], int aoff0, int aoff1, int boff0, int boff1) {
    if (NTW == 2) {
#pragma unroll
        for (int ks = 0; ks < 2; ++ks) {
            const int ao = ks ? aoff1 : aoff0, bo = ks ? boff1 : boff0;
            bf16x8 bfr[NTW];
#pragma unroll
            for (int nt = 0; nt < NTW; ++nt) bfr[nt] = *(const bf16x8*)(lb + bo + nt * 2048);
#pragma unroll
            for (int hh = 0; hh < 2; ++hh) {
                bf16x8 af[4];
#pragma unroll
                for (int mt = 0; mt < 4; ++mt) af[mt] = *(const bf16x8*)(la + ao + (hh * 4 + mt) * 2048);
                __builtin_amdgcn_sched_barrier(0);
#pragma unroll
                for (int mt = 0; mt < 4; ++mt)
#pragma unroll
                    for (int nt = 0; nt < NTW; ++nt) acc[hh * 4 + mt][nt] = __builtin_amdgcn_mfma_f32_16x16x32_bf16(bfr[nt], af[mt], acc[hh * 4 + mt][nt], 0, 0, 0);
                __builtin_amdgcn_sched_barrier(0);
            }
        }
        return;
    }
    bf16x8 b0[NTW], b1[NTW], a0[4], a1[4];
#define LDF(p) (*(const bf16x8*)(p))
#define MM16(HB, BF, AF) _Pragma("unroll") for (int mt = 0; mt < 4; ++mt) _Pragma("unroll") for (int nt = 0; nt < NTW; ++nt) \
        acc[HB + mt][nt] = __builtin_amdgcn_mfma_f32_16x16x32_bf16(BF[nt], AF[mt], acc[HB + mt][nt], 0, 0, 0);
#define SB __builtin_amdgcn_sched_barrier(0);
#pragma unroll
    for (int nt = 0; nt < NTW; ++nt) b0[nt] = LDF(lb + boff0 + nt * 2048);
#pragma unroll
    for (int mt = 0; mt < 4; ++mt) a0[mt] = LDF(la + aoff0 + mt * 2048);
#pragma unroll
    for (int mt = 0; mt < 4; ++mt) a1[mt] = LDF(la + aoff0 + (4 + mt) * 2048);
    SB MM16(0, b0, a0) SB
#pragma unroll
    for (int nt = 0; nt < NTW; ++nt) b1[nt] = LDF(lb + boff1 + nt * 2048);
#pragma unroll
    for (int mt = 0; mt < 4; ++mt) a0[mt] = LDF(la + aoff1 + mt * 2048);
    SB MM16(4, b0, a1) SB
#pragma unroll
    for (int mt = 0; mt < 4; ++mt) a1[mt] = LDF(la + aoff1 + (4 + mt) * 2048);
    SB MM16(0, b1, a0) SB
    MM16(4, b1, a1)
#undef LDF
#undef MM16
#undef SB
}
template <int NTW>
DEVI void gemm_kloop8(const bf16_t* __restrict__ A, int lda, const bf16_t* __restrict__ B, int ldb, int K, char* lds, f32x4 (&acc)[8][NTW], bool first, const bf16_t* nA, const bf16_t* nB) {
    LANE512
    const int aoff0 = swz<128>(wr * 128 + l15, quad), aoff1 = swz<128>(wr * 128 + l15, 4 + quad);
    const int boff0 = swz<128>(wc * (NTW * 16) + l15, quad), boff1 = swz<128>(wc * (NTW * 16) + l15, 4 + quad);
    const int srow = tid5 >> 3, sc = (tid5 & 7) ^ ((srow >> 1) & 7);
    const bf16_t* ga = A + (size_t)srow * lda + sc * 8;
    const bf16_t* gb = B + (size_t)srow * ldb + sc * 8;
    const int wbase = __builtin_amdgcn_readfirstlane(wave) * 1024;
    const int nk = K >> 6;
#define GLDS1(gp, lp) __builtin_amdgcn_global_load_lds((const unsigned*)(gp), (LDS_AS unsigned*)(lp), 16, 0, 0)
#define G_ISSUE(ls, k0) { char* l_ = (ls) + wbase; \
        GLDS1(ga + (k0), l_); GLDS1(ga + (size_t)64 * lda + (k0), l_ + 8192); GLDS1(ga + (size_t)128 * lda + (k0), l_ + 16384); GLDS1(ga + (size_t)192 * lda + (k0), l_ + 24576); \
        GLDS1(gb + (k0), l_ + 32768); GLDS1(gb + (size_t)64 * ldb + (k0), l_ + 32768 + 8192); \
        if (NTW == 4) { GLDS1(gb + (size_t)128 * ldb + (k0), l_ + 32768 + 16384); GLDS1(gb + (size_t)192 * ldb + (k0), l_ + 32768 + 24576); } }
    if (first) { __syncthreads();
        G_ISSUE(lds, 0) }
    asm volatile("s_waitcnt vmcnt(0)" ::: "memory");
    __syncthreads();
    for (int kt = 0; kt < nk; ++kt) {
        if (kt + 1 < nk) { char* ls = lds + ((kt + 1) & 1) * 65536; const int k0 = (kt + 1) << 6; G_ISSUE(ls, k0) }
        else if (nA) { ga = nA + (size_t)srow * lda + sc * 8; gb = nB + (size_t)srow * ldb + sc * 8; G_ISSUE(lds, 0) }
        __builtin_amdgcn_sched_barrier(0);
        const char* la = lds + (kt & 1) * 65536;
        compute_tile8<NTW>(la, la + 32768, acc, aoff0, aoff1, boff0, boff1);
        if (kt + 1 < nk) {
            asm volatile("s_waitcnt vmcnt(0)" ::: "memory");
            __syncthreads();
        }
    }
#undef G_ISSUE
#undef GLDS1
}
template <int NTW>
DEVI void zero_acc8(f32x4 (&acc)[8][NTW]) {
#pragma unroll
    for (int a = 0; a < 8; ++a)
#pragma unroll
        for (int b = 0; b < NTW; ++b) acc[a][b] = (f32x4){0.f, 0.f, 0.f, 0.f};
}
DEVI void tile_decode8(int t, int NT, int& mt, int& nt) { const int xcd = t & 7, s = t >> 3, mi = s & 3, q = s >> 2; nt = q % NT; const int mg = q / NT; mt = xcd * 8 + mg * 4 + mi; }

template <int NTW>
DEVI void zero_acc(f32x4 (&acc)[4][NTW]) {
#pragma unroll
    for (int a = 0; a < 4; ++a)
#pragma unroll
        for (int b = 0; b < NTW; ++b) acc[a][b] = (f32x4){0.f, 0.f, 0.f, 0.f};
}
DEVI void tile_decode(int t, int NT, int& mt, int& nt) { const int xcd = t & 7, s = t >> 3, mi = s & 3, q = s >> 2; nt = q % NT; const int mg = q / NT; mt = ((mg << 3) + xcd) * 4 + mi; }


DEVI void stage_rstd(const float* ss, int m0, char* lds_all) {
    float* part = (float*)(lds_all + 131072); float* rs = part + 512;
    const int t5 = TID512(), r = t5 & 255, half = t5 >> 8;
    float sacc = 0.f;
#pragma unroll
    for (int i = 0; i < 8; ++i) sacc += ss[(size_t)(half * 8 + i) * M + m0 + r];
    __syncthreads();
    part[t5] = sacc;
    __syncthreads();
    if (t5 < 256) rs[t5] = rsqrtf((part[t5] + part[t5 + 256]) * (1.f / 1024.f) + EPS);
}
DEVI void epi_swiglu(f32x4 (&acc)[8][4], int m0, int n0, const float* rs, bf16_t* H) {
    LANE512
#pragma unroll
    for (int mt = 0; mt < 8; ++mt) {
        const int row = m0 + wr * 128 + mt * 16 + l15;
        const float rstd = rs[wr * 128 + mt * 16 + l15];
#pragma unroll
        for (int pp = 0; pp < 2; ++pp) {
            f32x4 a = acc[mt][2 * pp] * rstd, b = acc[mt][2 * pp + 1] * rstd, h;
#pragma unroll
            for (int j = 0; j < 4; ++j) h[j] = a[j] * sigm(a[j]) * b[j];
            *(uint2*)(H + (size_t)row * FF + (n0 >> 1) + wc * 32 + pp * 16 + quad * 4) = pk4(h);
        }
    }
}
DEVI void epi_swiglu2(f32x4 (&acc)[8][2], int m0, int n0h, const float* rs, bf16_t* H) {
    LANE512
#pragma unroll
    for (int mt = 0; mt < 8; ++mt) {
        const int row = m0 + wr * 128 + mt * 16 + l15;
        const float rstd = rs[wr * 128 + mt * 16 + l15];
        const f32x4 a = acc[mt][0] * rstd, b = acc[mt][1] * rstd;
        f32x4 h;
#pragma unroll
        for (int j = 0; j < 4; ++j) h[j] = a[j] * sigm(a[j]) * b[j];
        *(uint2*)(H + (size_t)row * FF + (n0h >> 1) + wc * 16 + quad * 4) = pk4(h);
    }
}
DEVI void epi_resid(f32x4 (&acc)[8][4], int m0, int n0, float* X, bf16_t* XB, float* ssout, float scale, bool dry) {
    LANE512
#pragma unroll
    for (int mt = 0; mt < 8; ++mt) {
        const int row = m0 + wr * 128 + mt * 16 + l15;
        float part = 0.f;
#pragma unroll
        for (int nt = 0; nt < 4; ++nt) {
            const size_t off = (size_t)row * DM + n0 + wc * 64 + nt * 16 + quad * 4;
            f32x4 x = *(const f32x4*)(X + off);
            x += acc[mt][nt] * scale;
            if (!dry) { *(f32x4*)(X + off) = x; *(uint2*)(XB + off) = pk4(x); }
            part += x[0] * x[0] + x[1] * x[1] + x[2] * x[2] + x[3] * x[3];
        }
        part += __shfl_xor(part, 16); part += __shfl_xor(part, 32);
        if (quad == 0 && !dry) ssout[(size_t)((n0 >> 6) + wc) * M + row] = part;
    }
}
DEVI void epi_qx(f32x4 (&acc)[8][4], int m0, int n0, const float* rs, bf16_t* QX) {
    LANE512
#pragma unroll
    for (int mt = 0; mt < 8; ++mt) {
        const int row = m0 + wr * 128 + mt * 16 + l15;
        const float rstd = rs[wr * 128 + mt * 16 + l15];
#pragma unroll
        for (int nt = 0; nt < 4; ++nt) *(uint2*)(QX + (size_t)row * DM + n0 + wc * 64 + nt * 16 + quad * 4) = pk4(acc[mt][nt] * rstd);
    }
}
DEVI void epi_kv(f32x4 (&acc)[8][4], int m0, int n0, bf16_t* KX, bf16_t* VXT) {
    LANE512
    const int cb = n0 + wc * 64;
#pragma unroll
    for (int mt = 0; mt < 8; ++mt) {
        const int row = m0 + wr * 128 + mt * 16 + l15;
        if (cb < 1024) {
#pragma unroll
            for (int nt = 0; nt < 4; ++nt) *(uint2*)(KX + (size_t)row * 1024 + cb + nt * 16 + quad * 4) = pk4(acc[mt][nt]);
        } else {
            const int c2 = cb - 1024, h = c2 >> 8, d0 = c2 & 255, b = row >> 8, mm = row & 255;
#pragma unroll
            for (int nt = 0; nt < 4; ++nt)
#pragma unroll
                for (int j = 0; j < 4; ++j) VXT[((size_t)((b * 4 + h) * 256 + d0 + nt * 16 + quad * 4 + j)) * 256 + mm] = (bf16_t)f2bf(acc[mt][nt][j]);
        }
    }
}
DEVI void epi_mixin(f32x4 (&acc)[8][4], int m0, int n0, const Params& p, int l, const float* rs) {
    LANE512
    unsigned char* ws = WS(p);
    const int cb = n0 + wc * 64;
#define MIX_ROWS_BEGIN _Pragma("unroll") for (int mt = 0; mt < 8; ++mt) { const int row = m0 + wr * 128 + mt * 16 + l15; \
        const float rstd = rs[wr * 128 + mt * 16 + l15]; \
        f32x4 v0 = acc[mt][0] * rstd, v1 = acc[mt][1] * rstd, v2 = acc[mt][2] * rstd, v3 = acc[mt][3] * rstd;
#define MIX_ROWS_END }
    if (cb < 640) {
        const float* gn = (cb < 512 ? IN(p, 8) : IN(p, 9)) + l * 64;
        const f32x4 g0 = *(const f32x4*)(gn + quad * 4), g1 = *(const f32x4*)(gn + 16 + quad * 4), g2 = *(const f32x4*)(gn + 32 + quad * 4), g3 = *(const f32x4*)(gn + 48 + quad * 4);
        const float* cosT = (const float*)(ws + O_ROPE); const float* sinT = cosT + 1024;
        MIX_ROWS_BEGIN
            float s2 = v0[0] * v0[0] + v0[1] * v0[1] + v0[2] * v0[2] + v0[3] * v0[3] + v1[0] * v1[0] + v1[1] * v1[1] + v1[2] * v1[2] + v1[3] * v1[3]
                     + v2[0] * v2[0] + v2[1] * v2[1] + v2[2] * v2[2] + v2[3] * v2[3] + v3[0] * v3[0] + v3[1] * v3[1] + v3[2] * v3[2] + v3[3] * v3[3];
            s2 += __shfl_xor(s2, 16); s2 += __shfl_xor(s2, 32);
            const float rn = rsqrtf(s2 * (1.f / 64.f) + EPS);
            v0 = v0 * rn * g0; v1 = v1 * rn * g1; v2 = v2 * rn * g2; v3 = v3 * rn * g3;
            const int t = row & 4095, pr = t >> 6, pc = t & 63;
            const f32x4 cr = *(const f32x4*)(cosT + pr * 16 + quad * 4), sr = *(const f32x4*)(sinT + pr * 16 + quad * 4);
            const f32x4 cc = *(const f32x4*)(cosT + pc * 16 + quad * 4), sc2 = *(const f32x4*)(sinT + pc * 16 + quad * 4);
            const f32x4 o0 = v0 * cr - v1 * sr, o1 = v1 * cr + v0 * sr, o2 = v2 * cc - v3 * sc2, o3 = v3 * cc + v2 * sc2;
            bf16_t* dst = (cb < 512) ? ((bf16_t*)(ws + O_Q) + (size_t)row * 512 + cb) : ((bf16_t*)(ws + O_KB) + (size_t)row * 128 + (cb - 512));
            *(uint2*)(dst + 0 + quad * 4) = pk4(o0); *(uint2*)(dst + 16 + quad * 4) = pk4(o1);
            *(uint2*)(dst + 32 + quad * 4) = pk4(o2); *(uint2*)(dst + 48 + quad * 4) = pk4(o3);
        MIX_ROWS_END
    } else if (cb < 768) {
        const int kvh = (cb - 640) >> 6;
        bf16_t* VT = (bf16_t*)(ws + O_VT);
        MIX_ROWS_BEGIN
            const int b = row >> 12, t = row & 4095;
            bf16_t* vp = VT + ((size_t)((b * 2 + kvh) * 64 + quad * 4)) * 4096 + t;
#pragma unroll
            for (int j = 0; j < 4; ++j) {
                vp[(size_t)(j) * 4096] = (bf16_t)f2bf(v0[j]); vp[(size_t)(16 + j) * 4096] = (bf16_t)f2bf(v1[j]);
                vp[(size_t)(32 + j) * 4096] = (bf16_t)f2bf(v2[j]); vp[(size_t)(48 + j) * 4096] = (bf16_t)f2bf(v3[j]);
            }
        MIX_ROWS_END
    } else if (cb < 1280 || (cb >= 2304 && cb < 2816)) {
        bf16_t* base = (cb < 1280) ? ((bf16_t*)(ws + O_GU) + (cb - 768)) : ((bf16_t*)(ws + O_GY) + (cb - 2304));
        MIX_ROWS_BEGIN
            bf16_t* dp = base + (size_t)row * 512 + quad * 4;
            f32x4 a, b, c, d;
#pragma unroll
            for (int j = 0; j < 4; ++j) { a[j] = gelu_t(v0[j]); b[j] = gelu_t(v1[j]); c[j] = gelu_t(v2[j]); d[j] = gelu_t(v3[j]); }
            *(uint2*)(dp) = pk4(a); *(uint2*)(dp + 16) = pk4(b); *(uint2*)(dp + 32) = pk4(c); *(uint2*)(dp + 48) = pk4(d);
        MIX_ROWS_END
    } else if (cb < 1792) {
        bf16_t* GVT = (bf16_t*)(ws + O_GVT);
        float* ssg = SSP(p, l * 5 + 4) + (size_t)((cb - 1280) >> 6) * M;
        MIX_ROWS_BEGIN
            bf16_t* gp = GVT + ((size_t)((row >> 7) * 512 + (cb - 1280) + quad * 4)) * 128 + (row & 127);
            float s2 = 0.f;
#pragma unroll
            for (int j = 0; j < 4; ++j) {
                const float a = gelu_t(v0[j]), b = gelu_t(v1[j]), c = gelu_t(v2[j]), d = gelu_t(v3[j]);
                s2 += a * a + b * b + c * c + d * d;
                gp[(size_t)j * 128] = (bf16_t)f2bf(a); gp[(size_t)(16 + j) * 128] = (bf16_t)f2bf(b); gp[(size_t)(32 + j) * 128] = (bf16_t)f2bf(c); gp[(size_t)(48 + j) * 128] = (bf16_t)f2bf(d);
            }
            s2 += __shfl_xor(s2, 16); s2 += __shfl_xor(s2, 32);
            if (quad == 0) ssg[row] = s2;
        MIX_ROWS_END
    } else if (cb < 2304) {
        bf16_t* LX = (bf16_t*)(ws + O_LX) + (cb - 1792);
        MIX_ROWS_BEGIN
            bf16_t* dp = LX + (size_t)row * 512 + quad * 4;
            *(uint2*)(dp) = pk4(v0); *(uint2*)(dp + 16) = pk4(v1); *(uint2*)(dp + 32) = pk4(v2); *(uint2*)(dp + 48) = pk4(v3);
        MIX_ROWS_END
    } else {
        bf16_t* GT = (bf16_t*)(ws + O_GATES) + (cb - 2816);
        const float* bg = IN(p, 7) + (size_t)l * 3072 + (cb - 2816) + quad * 4;
        const f32x4 b0 = *(const f32x4*)(bg), b1 = *(const f32x4*)(bg + 16), b2 = *(const f32x4*)(bg + 32), b3 = *(const f32x4*)(bg + 48);
        MIX_ROWS_BEGIN
            bf16_t* dp = GT + (size_t)row * 3072 + quad * 4;
            f32x4 a, b, c, d;
#pragma unroll
            for (int j = 0; j < 4; ++j) { a[j] = sigm(v0[j] + b0[j]); b[j] = sigm(v1[j] + b1[j]); c[j] = sigm(v2[j] + b2[j]); d[j] = sigm(v3[j] + b3[j]); }
            *(uint2*)(dp) = pk4(a); *(uint2*)(dp + 16) = pk4(b); *(uint2*)(dp + 32) = pk4(c); *(uint2*)(dp + 48) = pk4(d);
        MIX_ROWS_END
    }
#undef MIX_ROWS_BEGIN
#undef MIX_ROWS_END
}

template <int D, int KT, int MT, bool ONLINE, bool DMA = false>
DEVI void attn_item(const bf16_t* __restrict__ Q, int ldq, const bf16_t* __restrict__ Kp, int ldk, const bf16_t* __restrict__ Vt, int ldv,
                    bf16_t* O, int ldo, int nkeys, float sc, float mfix, char* lds, bool dry) {
    LANE_VARS
    constexpr int NT = KT / 16, KS = D / 32, NTD = D / 16, KS2 = KT / 32;
    constexpr int KRB = D * 2, VRB = KT * 2, KBYTES = KT * D * 2, NCH = KT * D / 8 / 256, PB = MT * 16 * KT * 2;
    constexpr int KCPR = D / 8, VCPR = KT / 8;
    char* lK = lds; char* lV = lds + KBYTES; char* lP = lds + (DMA ? 32768 : 2 * KBYTES) + wave * PB;
    bf16x8 qf[MT][KS];
#pragma unroll
    for (int mt = 0; mt < MT; ++mt)
#pragma unroll
        for (int ks = 0; ks < KS; ++ks) qf[mt][ks] = *(const bf16x8*)(Q + (size_t)((wave * MT + mt) * 16 + l15) * ldq + ks * 32 + quad * 8);
    f32x4 o[MT][NTD];
    float mrow[MT], lrow[MT];
#pragma unroll
    for (int mt = 0; mt < MT; ++mt) { mrow[mt] = -1e30f; lrow[mt] = 0.f;
#pragma unroll
        for (int n = 0; n < NTD; ++n) o[mt][n] = (f32x4){0.f, 0.f, 0.f, 0.f}; }
    uint4 rk0, rk1, rk2, rk3, rv0, rv1, rv2, rv3;
    rk2 = rk3 = rv2 = rv3 = make_uint4(0, 0, 0, 0);
    const int tid = TIDX();
#define ATT_LD1(i, key0) if (NCH > i) { const int id = i * 256 + tid; \
        rk##i = *(const uint4*)(Kp + (size_t)((key0) + id / KCPR) * ldk + (id % KCPR) * 8); \
        rv##i = *(const uint4*)(Vt + (size_t)(id / VCPR) * ldv + (key0) + (id % VCPR) * 8); }
#define ATT_LOAD(key0) ATT_LD1(0, key0) ATT_LD1(1, key0) ATT_LD1(2, key0) ATT_LD1(3, key0)
#define ATT_ST1(i) if (NCH > i) { const int id = i * 256 + tid; \
        *(uint4*)(lK + swz<KRB>(id / KCPR, id % KCPR)) = rk##i; *(uint4*)(lV + swz<VRB>(id / VCPR, id % VCPR)) = rv##i; }
    const int drow = wave * 8 + (lane >> 3), dch = ((lane & 7) ^ ((drow >> 1) & 7)) * 8;
    const int wv1k = __builtin_amdgcn_readfirstlane(wave) * 1024;
#define ATT_DMA(key0, buf) { char* b_ = lds + (buf) * 16384 + wv1k; \
        __builtin_amdgcn_global_load_lds((const unsigned*)(Kp + (size_t)((key0) + drow) * ldk + dch), (LDS_AS unsigned*)(b_), 16, 0, 0); \
        __builtin_amdgcn_global_load_lds((const unsigned*)(Kp + (size_t)((key0) + 32 + drow) * ldk + dch), (LDS_AS unsigned*)(b_ + 4096), 16, 0, 0); \
        __builtin_amdgcn_global_load_lds((const unsigned*)(Vt + (size_t)drow * ldv + (key0) + dch), (LDS_AS unsigned*)(b_ + 8192), 16, 0, 0); \
        __builtin_amdgcn_global_load_lds((const unsigned*)(Vt + (size_t)(32 + drow) * ldv + (key0) + dch), (LDS_AS unsigned*)(b_ + 8192 + 4096), 16, 0, 0); }
    if (DMA) { ATT_DMA(0, 0) } else { ATT_LOAD(0) }
    const int ntile = nkeys / KT;
    for (int kt = 0; kt < ntile; ++kt) {
        if (DMA) {
            asm volatile("s_waitcnt vmcnt(0)" ::: "memory");
            __syncthreads();
            if (kt + 1 < ntile) { const int key0 = (kt + 1) * KT; ATT_DMA(key0, (kt + 1) & 1) }
            lK = lds + (kt & 1) * 16384; lV = lK + 8192;
        } else {
        __syncthreads();
        ATT_ST1(0) ATT_ST1(1) ATT_ST1(2) ATT_ST1(3)
        __syncthreads();
        if (kt + 1 < ntile) { const int key0 = (kt + 1) * KT; ATT_LOAD(key0) }
        }
        __builtin_amdgcn_sched_barrier(0);
        f32x4 s[MT][NT];
#pragma unroll
        for (int mt = 0; mt < MT; ++mt)
#pragma unroll
            for (int nt = 0; nt < NT; ++nt) s[mt][nt] = (f32x4){0.f, 0.f, 0.f, 0.f};
        constexpr bool WIDE = (D == 64);
        bf16x8 vfa[WIDE ? KS2 : 1][WIDE ? NTD : 1];
        if (WIDE) {
            bf16x8 kfa[KS][NT];
#pragma unroll
            for (int ks = 0; ks < KS; ++ks)
#pragma unroll
                for (int nt = 0; nt < NT; ++nt) kfa[ks][nt] = *(const bf16x8*)(lK + swz<KRB>(nt * 16 + l15, ks * 4 + quad));
            __builtin_amdgcn_sched_barrier(0);
#pragma unroll
            for (int ks = 0; ks < KS; ++ks)
#pragma unroll
                for (int nt = 0; nt < NT; ++nt)
#pragma unroll
                    for (int mt = 0; mt < MT; ++mt) s[mt][nt] = __builtin_amdgcn_mfma_f32_16x16x32_bf16(kfa[ks][nt], qf[mt][ks], s[mt][nt], 0, 0, 0);
            __builtin_amdgcn_sched_barrier(0);
#pragma unroll
            for (int k2 = 0; k2 < KS2; ++k2)
#pragma unroll
                for (int n = 0; n < NTD; ++n) vfa[k2][n] = *(const bf16x8*)(lV + swz<VRB>(n * 16 + l15, k2 * 4 + quad));
            __builtin_amdgcn_sched_barrier(0);
        } else {
#pragma unroll
        for (int ks = 0; ks < KS; ++ks) {
            bf16x8 kf[NT];
#pragma unroll
            for (int nt = 0; nt < NT; ++nt) kf[nt] = *(const bf16x8*)(lK + swz<KRB>(nt * 16 + l15, ks * 4 + quad));
            __builtin_amdgcn_sched_barrier(0);
#pragma unroll
            for (int nt = 0; nt < NT; ++nt)
#pragma unroll
                for (int mt = 0; mt < MT; ++mt) s[mt][nt] = __builtin_amdgcn_mfma_f32_16x16x32_bf16(kf[nt], qf[mt][ks], s[mt][nt], 0, 0, 0);
            __builtin_amdgcn_sched_barrier(0);
        }
        }
#pragma unroll
        for (int mt = 0; mt < MT; ++mt) {
            if (!ONLINE) {
                f32x4 rs4 = (f32x4){0.f, 0.f, 0.f, 0.f};
#pragma unroll
                for (int nt = 0; nt < NT; ++nt) {
                    const f32x4 e = s[mt][nt] * sc - mfix;
                    f32x4 pv;
#pragma unroll
                    for (int j = 0; j < 4; ++j) pv[j] = __builtin_amdgcn_exp2f(e[j]);
                    rs4 += pv;
                    *(uint2*)(lP + swz<VRB>(mt * 16 + l15, nt * 2 + (quad >> 1)) + (quad & 1) * 8) = pk4(pv);
                }
                lrow[mt] += (rs4[0] + rs4[1]) + (rs4[2] + rs4[3]);
                continue;
            }
            float mx = -1e30f;
#pragma unroll
            for (int nt = 0; nt < NT; ++nt) mx = fmaxf(mx, fmaxf(fmaxf(s[mt][nt][0], s[mt][nt][1]), fmaxf(s[mt][nt][2], s[mt][nt][3])));
            mx = fmaxf(mx, __shfl_xor(mx, 16)); mx = fmaxf(mx, __shfl_xor(mx, 32));
            const float mnew = fmaxf(mrow[mt], mx * sc);
            const float alpha = __builtin_amdgcn_exp2f(mrow[mt] - mnew);
            mrow[mt] = mnew;
            float rs = 0.f;
#pragma unroll
            for (int nt = 0; nt < NT; ++nt) {
                f32x4 pv;
#pragma unroll
                for (int j = 0; j < 4; ++j) { pv[j] = __builtin_amdgcn_exp2f(s[mt][nt][j] * sc - mnew); rs += pv[j]; }
                *(uint2*)(lP + swz<VRB>(mt * 16 + l15, nt * 2 + (quad >> 1)) + (quad & 1) * 8) = pk4(pv);
            }
            lrow[mt] = lrow[mt] * alpha + rs;
#pragma unroll
            for (int n = 0; n < NTD; ++n) o[mt][n] *= alpha;
        }
        asm volatile("" ::: "memory");
        if (WIDE) {
            bf16x8 pfa[KS2][MT];
#pragma unroll
            for (int k2 = 0; k2 < KS2; ++k2)
#pragma unroll
                for (int mt = 0; mt < MT; ++mt) pfa[k2][mt] = *(const bf16x8*)(lP + swz<VRB>(mt * 16 + l15, k2 * 4 + quad));
            __builtin_amdgcn_sched_barrier(0);
#pragma unroll
            for (int k2 = 0; k2 < KS2; ++k2)
#pragma unroll
                for (int n = 0; n < NTD; ++n)
#pragma unroll
                    for (int mt = 0; mt < MT; ++mt) o[mt][n] = __builtin_amdgcn_mfma_f32_16x16x32_bf16(vfa[k2][n], pfa[k2][mt], o[mt][n], 0, 0, 0);
            __builtin_amdgcn_sched_barrier(0);
        } else
#pragma unroll
        for (int k2 = 0; k2 < KS2; ++k2) {
            bf16x8 pf[MT];
#pragma unroll
            for (int mt = 0; mt < MT; ++mt) pf[mt] = *(const bf16x8*)(lP + swz<VRB>(mt * 16 + l15, k2 * 4 + quad));
#pragma unroll
            for (int n0 = 0; n0 < NTD; n0 += 4) {
                bf16x8 vf[4];
#pragma unroll
                for (int n = 0; n < 4; ++n) vf[n] = *(const bf16x8*)(lV + swz<VRB>((n0 + n) * 16 + l15, k2 * 4 + quad));
                __builtin_amdgcn_sched_barrier(0);
#pragma unroll
                for (int n = 0; n < 4; ++n)
#pragma unroll
                    for (int mt = 0; mt < MT; ++mt) o[mt][n0 + n] = __builtin_amdgcn_mfma_f32_16x16x32_bf16(vf[n], pf[mt], o[mt][n0 + n], 0, 0, 0);
                __builtin_amdgcn_sched_barrier(0);
            }
        }
    }
#undef ATT_LOAD
#undef ATT_LD1
#undef ATT_ST1
#undef ATT_DMA
#pragma unroll
    for (int mt = 0; mt < MT; ++mt) {
        float l = lrow[mt]; l += __shfl_xor(l, 16); l += __shfl_xor(l, 32);
        const float inv = 1.f / l;
        bf16_t* op = O + (size_t)((wave * MT + mt) * 16 + l15) * ldo + quad * 4;
#pragma unroll
        for (int n = 0; n < NTD; ++n) { const uint2 w = pk4(o[mt][n] * inv); if (!dry) *(uint2*)(op + n * 16) = w; else asm volatile("" :: "v"(w.x), "v"(w.y)); }
    }
}

DEVI void gmlp_item(const Params& p, int l, int item, char* lds, char* rs_lds, bool dry) {
    LANE_VARS
    const int tid = TIDX(), g = item & 3, bc = item >> 2, row0 = bc * 128;
    unsigned char* wsb = WS(p);
    const bf16_t* WSg = (const bf16_t*)(wsb + O_W) + W_GWS + (size_t)g * 16384;
    const bf16_t* GVT = (const bf16_t*)(wsb + O_GVT) + ((size_t)bc * 512 + g * 128) * 128;
    const float* ssg = SSP(p, l * 5 + 4) + row0;
    const float* gain = IN(p, 11) + l * 512 + g * 128;
    const int srow = tid >> 3, sc = tid & 7;
    float* rsl = (float*)rs_lds;
    __syncthreads();
    if (tid < 128) rsl[tid] = rsqrtf(ss_sum<8>(ssg, tid) * (1.f / 512.f) + EPS);
    __syncthreads();
#pragma unroll
    for (int kt = 0; kt < 2; ++kt) {
        float rs[8];
#pragma unroll
        for (int e = 0; e < 8; ++e) rs[e] = rsl[kt * 64 + sc * 8 + e];
#pragma unroll
        for (int i = 0; i < 4; ++i) {
            const int r = srow + 32 * i;
            const uint4 a = *(const uint4*)(WSg + (size_t)r * 128 + kt * 64 + sc * 8);
            *(uint4*)(lds + kt * 32768 + swz<128>(r, sc)) = a;
            const uint4 bv = *(const uint4*)(GVT + (size_t)r * 128 + kt * 64 + sc * 8);
            const float gn = gain[r];
            const unsigned w[4] = {bv.x, bv.y, bv.z, bv.w};
            unsigned ow[4];
#pragma unroll
            for (int e = 0; e < 4; ++e) ow[e] = pk2(bf2f(w[e] & 0xffffu) * rs[2 * e] * gn, bf2f(w[e] >> 16) * rs[2 * e + 1] * gn);
            *(uint4*)(lds + kt * 32768 + 16384 + swz<128>(r, sc)) = make_uint4(ow[0], ow[1], ow[2], ow[3]);
        }
    }
    __syncthreads();
    f32x4 acc[4][4]; zero_acc<4>(acc);
    KT_OFFS(4)
    compute_ktile<4>(lds, lds + 16384, acc, aoff0, aoff1, boff0, boff1);
    compute_ktile<4>(lds + 32768, lds + 32768 + 16384, acc, aoff0, aoff1, boff0, boff1);
    const float* bs = IN(p, 13) + l * 512 + g * 128;
    bf16_t* GU = (bf16_t*)(wsb + O_GU);
#pragma unroll
    for (int mt = 0; mt < 4; ++mt) {
        const int pr = wr * 64 + mt * 16 + l15;
        const float bias = bs[pr];
#pragma unroll
        for (int nt = 0; nt < 4; ++nt) {
            bf16_t* up = GU + (size_t)(row0 + pr) * 512 + g * 128 + wc * 64 + nt * 16 + quad * 4;
            const f32x4 u = unpk4(*(const uint2*)up);
            const uint2 w = pk4(u * (acc[mt][nt] + bias)); if (!dry) *(uint2*)up = w; else asm volatile("" :: "v"(w.x), "v"(w.y));
        }
    }
}

template <int DIR, int PASS>
DEVI void lru_dir(const Params& p, int l, int b, int ck, int h, char* lds, bool dry) {
    LANE_VARS
    const int tid = TIDX();
    const bf16_t* W = (const bf16_t*)(WS(p) + O_W);
    float* sA = (float*)(lds + 8192); float* sB = (float*)(lds + 24576);
    float2* pagg = (float2*)(lds + 40960); float* carry = (float*)(lds + 43008); float* sHF = (float*)(lds + 45056);
    bf16x8 xf[2];
#pragma unroll
    for (int ks = 0; ks < 2; ++ks) xf[ks] = *(const bf16x8*)(lds + swz<128>(wave * 16 + l15, ks * 4 + quad));
    f32x4 aA[4], aI[4];
    const bf16_t* wa = W + W_LWA + (size_t)(DIR * 8 + h) * 4096;
    const bf16_t* wi = W + W_LWI + (size_t)(DIR * 8 + h) * 4096;
#pragma unroll
    for (int nt = 0; nt < 4; ++nt) {
        aA[nt] = (f32x4){0.f, 0.f, 0.f, 0.f}; aI[nt] = (f32x4){0.f, 0.f, 0.f, 0.f};
#pragma unroll
        for (int ks = 0; ks < 2; ++ks) {
            const bf16x8 fa = *(const bf16x8*)(wa + (nt * 16 + l15) * 64 + ks * 32 + quad * 8);
            const bf16x8 fi = *(const bf16x8*)(wi + (nt * 16 + l15) * 64 + ks * 32 + quad * 8);
            aA[nt] = __builtin_amdgcn_mfma_f32_16x16x32_bf16(fa, xf[ks], aA[nt], 0, 0, 0);
            aI[nt] = __builtin_amdgcn_mfma_f32_16x16x32_bf16(fi, xf[ks], aI[nt], 0, 0, 0);
        }
    }
    const int t = wave * 16 + l15;
#pragma unroll
    for (int nt = 0; nt < 4; ++nt) {
        const int chb = nt * 16 + quad * 4, gch = (l * 2 + DIR) * 512 + h * 64 + chb;
        const f32x4 ba4 = *(const f32x4*)(IN(p, 18) + gch), bi4 = *(const f32x4*)(IN(p, 20) + gch), sp4 = *(const f32x4*)((const float*)(WS(p) + O_SP) + DIR * 512 + h * 64 + chb);
        const f32x4 x4 = unpk4(*(const uint2*)(lds + swz<128>(t, nt * 2 + (quad >> 1)) + (quad & 1) * 8));
        f32x4 av, bv;
#pragma unroll
        for (int j = 0; j < 4; ++j) {
            const float r = sigm(aA[nt][j] + ba4[j]), ii = sigm(aI[nt][j] + bi4[j]);
            const float la = -8.f * r * sp4[j];
            const float a = __expf(la);
            av[j] = a;
            const float x = 2.f * la;
            const float ser = -x * (1.f + x * (0.5f + x * (0.16666667f + x * (0.041666668f + x * (0.008333334f + x * 0.0013888889f)))));
            const float om = (x > -0.25f) ? ser : (1.f - a * a);
            bv[j] = __builtin_amdgcn_sqrtf(om) * ii * x4[j];
        }
        *(f32x4*)(sA + t * 64 + chb) = av; *(f32x4*)(sB + t * 64 + chb) = bv;
    }
    __syncthreads();
    const int ch = tid & 63, part = wave;
    float A = 1.f, B = 0.f;
#pragma unroll
    for (int k = 0; k < 16; ++k) { const int tt = part * 16 + (DIR == 0 ? k : 15 - k); const float a = sA[tt * 64 + ch], bb = sB[tt * 64 + ch]; B = a * B + bb; A *= a; }
    pagg[part * 64 + ch] = make_float2(A, B);
    __syncthreads();
    if (PASS == 1) {
        if (part == 0) {
            float At = 1.f, Bt = 0.f;
#pragma unroll
            for (int q = 0; q < 4; ++q) { const int pp = DIR == 0 ? q : 3 - q; const float2 ab = pagg[pp * 64 + ch]; Bt = ab.x * Bt + ab.y; At *= ab.x; }
            ((float2*)(WS(p) + O_AGG))[((size_t)((b * 2 + DIR) * 64 + ck)) * 512 + h * 64 + ch] = make_float2(At, Bt);
        }
    } else {
        float hin = carry[DIR * 64 + ch];
#pragma unroll
        for (int q = 0; q < 4; ++q) { const int pp = DIR == 0 ? q : 3 - q; const bool before = DIR == 0 ? (pp < part) : (pp > part);
            if (before) { const float2 ab = pagg[pp * 64 + ch]; hin = ab.x * hin + ab.y; } }
        bf16_t* GY = (bf16_t*)(WS(p) + O_GY);
#pragma unroll
        for (int k = 0; k < 16; ++k) {
            const int tt = part * 16 + (DIR == 0 ? k : 15 - k);
            hin = sA[tt * 64 + ch] * hin + sB[tt * 64 + ch];
            if (DIR == 0) sHF[tt * 64 + ch] = hin;
            else { bf16_t* gp = GY + (size_t)(b * 4096 + ck * 64 + tt) * 512 + h * 64 + ch; const unsigned w = f2bf((sHF[tt * 64 + ch] + hin) * bf2f(*gp)); if (!dry) *gp = (bf16_t)w; else asm volatile("" :: "v"(w)); }
        }
    }
    __syncthreads();
}
template <int PASS>
DEVI void lru_items(const Params& p, int l, int item0, int nitem, int stride, char* lds, bool dry) {
    const int tid = TIDX(), h = item0 & 7;
    const int c8 = tid & 7, chg = h * 64 + c8 * 8;
    float w[4][8], cb[8];
    {
        const f32x4 c0 = *(const f32x4*)(IN(p, 16) + l * 512 + chg), c1 = *(const f32x4*)(IN(p, 16) + l * 512 + chg + 4);
#pragma unroll
        for (int e = 0; e < 4; ++e) { cb[e] = c0[e]; cb[4 + e] = c1[e]; }
#pragma unroll
        for (int j = 0; j < 4; ++j) {
            const f32x4 w0 = *(const f32x4*)(IN(p, 15) + (l * 4 + j) * 512 + chg), w1 = *(const f32x4*)(IN(p, 15) + (l * 4 + j) * 512 + chg + 4);
#pragma unroll
            for (int e = 0; e < 4; ++e) { w[j][e] = w0[e]; w[j][4 + e] = w1[e]; }
        }
    }
    for (int ii = 0; ii < nitem; ++ii) {
    const int item = item0 + ii * stride, ck = (item >> 3) & 63, b = item >> 9;
    __syncthreads();
    {
        const bf16_t* LX = (const bf16_t*)(WS(p) + O_LX);
#pragma unroll
        for (int it = 0; it < 2; ++it) {
            const int t = (tid >> 3) + 32 * it, s = ck * 64 + t;
            float a8[8];
#pragma unroll
            for (int e = 0; e < 8; ++e) a8[e] = cb[e];
#pragma unroll
            for (int j = 0; j < 4; ++j) {
                const int s2 = s + j - 2;
                if (s2 >= 0 && s2 < 4096) {
                    const uint4 raw = *(const uint4*)(LX + (size_t)(b * 4096 + s2) * 512 + chg);
                    const unsigned rw[4] = {raw.x, raw.y, raw.z, raw.w};
#pragma unroll
                    for (int e = 0; e < 4; ++e) { a8[2 * e] += w[j][2 * e] * bf2f(rw[e] & 0xffffu); a8[2 * e + 1] += w[j][2 * e + 1] * bf2f(rw[e] >> 16); }
                }
            }
            *(uint4*)(lds + swz<128>(t, c8)) = make_uint4(pk2(a8[0], a8[1]), pk2(a8[2], a8[3]), pk2(a8[4], a8[5]), pk2(a8[6], a8[7]));
        }
    }
    if (PASS == 3) {
        float2* stg = (float2*)(lds + 8192);
        const int ch = tid & 63;
        const float2* aggb = (const float2*)(WS(p) + O_AGG) + h * 64 + ch;
#pragma unroll
        for (int i = 0; i < 16; ++i) {
            const int c2 = (tid >> 6) + 4 * i;
            if (c2 != ck) { const int dir = c2 < ck ? 0 : 1; stg[c2 * 64 + ch] = aggb[((size_t)(b * 2 + dir) * 64 + c2) * 512]; }
        }
        __syncthreads();
        if (tid < 128) {
            const int dir = tid >> 6;
            float hc = 0.f;
            if (dir == 0) { for (int c2 = 0; c2 < ck; ++c2) { const float2 ab = stg[c2 * 64 + ch]; hc = ab.x * hc + ab.y; } }
            else { for (int c2 = 63; c2 > ck; --c2) { const float2 ab = stg[c2 * 64 + ch]; hc = ab.x * hc + ab.y; } }
            ((float*)(lds + 43008))[dir * 64 + ch] = hc;
        }
    }
    __syncthreads();
    lru_dir<0, PASS>(p, l, b, ck, h, lds, dry);
    lru_dir<1, PASS>(p, l, b, ck, h, lds, dry);
    }
}

DEVI void tjob(const float* __restrict__ src, bf16_t* __restrict__ dst, int K, int N, const float* gain, int perm, char* lds, int& toff, int vbid, int VG) {
    float* lf = (float*)lds;
    const int tid = TIDX(), tilesK = K >> 6, ntiles = tilesK * (N >> 6);
    const int start = (vbid - (toff % VG) + VG) % VG;
    toff += ntiles;
    const int iters = (ntiles + VG - 1) / VG;
    float v[16];
#define TJ_LOAD(t_) { const int tk_ = (t_) % tilesK, tn_ = (t_) / tilesK; const int np = tn_ * 64 + (tid & 15) * 4; int scol = np; \
        if (perm) { const int g = np >> 5, w = np & 31; scol = (w < 16) ? (g * 16 + w) : (2816 + g * 16 + w - 16); } \
        _Pragma("unroll") for (int i = 0; i < 4; ++i) { const int k = tk_ * 64 + (tid >> 4) + 16 * i; f32x4 x = *(const f32x4*)(src + (size_t)k * N + scol); if (gain) x *= gain[k]; \
            v[4 * i] = x[0]; v[4 * i + 1] = x[1]; v[4 * i + 2] = x[2]; v[4 * i + 3] = x[3]; } }
    if (start < ntiles) TJ_LOAD(start)
    for (int it = 0; it < iters; ++it) {
        const int t = start + it * VG;
        const bool act = t < ntiles;
        const int tk = t % tilesK, tn = t / tilesK;
        __syncthreads();
        if (act) {
#pragma unroll
            for (int i = 0; i < 4; ++i)
#pragma unroll
                for (int e = 0; e < 4; ++e) lf[((tid >> 4) + 16 * i) * 65 + (tid & 15) * 4 + e] = v[4 * i + e];
        }
        if (t + VG < ntiles) TJ_LOAD(t + VG)
        __syncthreads();
        if (act) {
            const int nl = tid >> 2, kb = (tid & 3) * 16;
            unsigned w[8];
#pragma unroll
            for (int e = 0; e < 8; ++e) w[e] = pk2(lf[(kb + 2 * e) * 65 + nl], lf[(kb + 2 * e + 1) * 65 + nl]);
            bf16_t* dp = dst + (size_t)(tn * 64 + nl) * K + tk * 64 + kb;
            *(uint4*)dp = make_uint4(w[0], w[1], w[2], w[3]);
            *(uint4*)(dp + 8) = make_uint4(w[4], w[5], w[6], w[7]);
        }
    }
#undef TJ_LOAD
}
DEVI void convert_weights(const Params& p, int l, char* lds, int vbid, int VG) {
    asm volatile("" : "+s"(VG));
    bf16_t* W = (bf16_t*)(WS(p) + O_W);
    int toff = 0;
    tjob(IN(p, 3) + (size_t)l * 1024 * 5632, W + W_1IN, 1024, 5632, IN(p, 2) + l * 1024, 1, lds, toff, vbid, VG);
    tjob(IN(p, 4) + (size_t)l * 2816 * 1024, W + W_1OUT, 2816, 1024, nullptr, 0, lds, toff, vbid, VG);
    tjob(IN(p, 6) + (size_t)l * 1024 * 5888, W + W_MIX, 1024, 5888, IN(p, 5) + l * 1024, 0, lds, toff, vbid, VG);
    tjob(IN(p, 10) + (size_t)l * 512 * 1024, W + W_AU, 512, 1024, nullptr, 0, lds, toff, vbid, VG);
    tjob(IN(p, 14) + (size_t)l * 512 * 1024, W + W_GU, 512, 1024, nullptr, 0, lds, toff, vbid, VG);
    tjob(IN(p, 22) + (size_t)l * 512 * 1024, W + W_LU, 512, 1024, nullptr, 0, lds, toff, vbid, VG);
    tjob(IN(p, 23) + (size_t)l * 1024 * 1024, W + W_MO, 1024, 1024, nullptr, 0, lds, toff, vbid, VG);
    tjob(IN(p, 26) + (size_t)l * 1024 * 1024, W + W_Q, 1024, 1024, IN(p, 24) + l * 1024, 0, lds, toff, vbid, VG);
    tjob(IN(p, 27) + (size_t)l * 1024 * 2048, W + W_KV, 1024, 2048, nullptr, 0, lds, toff, vbid, VG);
    tjob(IN(p, 28) + (size_t)l * 1024 * 1024, W + W_O, 1024, 1024, nullptr, 0, lds, toff, vbid, VG);
    tjob(IN(p, 30) + (size_t)l * 1024 * 5632, W + W_2IN, 1024, 5632, IN(p, 29) + l * 1024, 1, lds, toff, vbid, VG);
    tjob(IN(p, 31) + (size_t)l * 2816 * 1024, W + W_2OUT, 2816, 1024, nullptr, 0, lds, toff, vbid, VG);
    const int gt = vbid * 256 + TIDX(), gs = VG * 256;
    for (int i = gt; i < 65536; i += gs) {
        const int mat = i >> 12, o = (i >> 6) & 63, ii = i & 63;
        W[W_LWA + i] = (bf16_t)f2bf(IN(p, 17)[(size_t)l * 65536 + mat * 4096 + ii * 64 + o]);
        W[W_LWI + i] = (bf16_t)f2bf(IN(p, 19)[(size_t)l * 65536 + mat * 4096 + ii * 64 + o]);
        W[W_GWS + i] = (bf16_t)f2bf(IN(p, 12)[(size_t)l * 65536 + i]);
    }
    for (int i = gt; i < 1024; i += gs) ((float*)(WS(p) + O_SP))[i] = log1pf(expf(-IN(p, 21)[l * 1024 + i]));
    bf16_t* MEMN = (bf16_t*)(WS(p) + O_MEMN);
    const int lane = TIDX() & 63, gw = vbid * 4 + (TIDX() >> 6), nw = VG * 4;
    for (int row = gw; row < 1024; row += nw) {
        f32x4 v[4]; float s = 0.f;
#pragma unroll
        for (int i = 0; i < 4; ++i) { v[i] = *(const f32x4*)(IN(p, 1) + (size_t)row * 1024 + i * 256 + lane * 4); s += v[i][0] * v[i][0] + v[i][1] * v[i][1] + v[i][2] * v[i][2] + v[i][3] * v[i][3]; }
        s = wave_sum(s);
        const float rstd = rsqrtf(s * (1.f / 1024.f) + EPS);
#pragma unroll
        for (int i = 0; i < 4; ++i) { const f32x4 g = *(const f32x4*)(IN(p, 25) + l * 1024 + i * 256 + lane * 4); *(uint2*)(MEMN + (size_t)row * 1024 + i * 256 + lane * 4) = pk4(v[i] * rstd * g); }
    }
}

DEVI void run_phase(const Params& p, int ph, char* lds_all, bool dry) {
    unsigned char* ws = WS(p);
    bf16_t* W = (bf16_t*)(ws + O_W);
    bf16_t* XB = (bf16_t*)(ws + O_XB);
    float* X = p.out;
    const int RG = gridDim.x, rbid = blockIdx.x;
    const int vb = __builtin_amdgcn_readfirstlane(TID512() >> 8);
    const int G = RG * 2, bid = rbid * 2 + vb, tid = TIDX(), lane = tid & 63;
    char* lds = lds_all + vb * 65536;
    if (ph == 0) {
        convert_weights(p, 0, lds, bid, G);
        const int gw = bid * 4 + (tid >> 6), nw = G * 4;
        float* ss0 = SSP(p, 0);
        for (int row = gw; row < M; row += nw) {
            float s = 0.f;
#pragma unroll
            for (int i = 0; i < 4; ++i) {
                const size_t off = (size_t)row * 1024 + i * 256 + lane * 4;
                const f32x4 v = *(const f32x4*)(IN(p, 0) + off);
                *(f32x4*)(X + off) = v; *(uint2*)(XB + off) = pk4(v);
                s += v[0] * v[0] + v[1] * v[1] + v[2] * v[2] + v[3] * v[3];
            }
            s = wave_sum(s);
            if (lane < 16) ss0[(size_t)lane * M + row] = (lane == 0) ? s : 0.f;
        }
        if (bid == 0) for (int i = tid; i < 3456; i += 256) __hip_atomic_store((unsigned*)(ws + O_BAR) + i, 0u, __ATOMIC_RELAXED, __HIP_MEMORY_SCOPE_AGENT);
        if (bid == 0) {
            float* cosT = (float*)(ws + O_ROPE); float* sinT = cosT + 1024;
            for (int i = tid; i < 1024; i += 256) {
                const int pos = i >> 4, f = i & 15;
                const float inv = powf(10000.f, -(float)f / 16.f);
                const float ang = (float)pos * inv;
                cosT[i] = cosf(ang); sinT[i] = sinf(ang);
            }
        }
        return;
    }
    const int l = (ph - 1) / 13, q = (ph - 1) % 13;
    switch (q) {
    case 0: case 10: {
        const bf16_t* Bw = W + (q == 0 ? W_1IN : W_2IN);
        const float* ss = SSP(p, l * 5 + (q == 0 ? 0 : 3));
        const int nt1 = 64 * 22, ntot = (q == 0) ? nt1 + 32 : (nt1 / RG) * RG;
        int rs_mt = -1;
        for (int t = rbid; t < ntot; t += RG) {
            f32x4 acc[8][4]; zero_acc8<4>(acc);
            int mt, nt; const bf16_t* cA; const bf16_t* cB; const bf16_t* nA = nullptr; const bf16_t* nB = nullptr;
            if (t < nt1) { tile_decode8(t, 22, mt, nt); cA = XB + (size_t)mt * 256 * DM; cB = Bw + (size_t)nt * 256 * DM; }
            else { const int t2 = t - nt1; mt = t2 & 3; nt = t2 >> 2; cA = (const bf16_t*)(ws + O_MEMN) + (size_t)mt * 256 * DM; cB = W + W_KV + (size_t)nt * 256 * DM; }
            const int tn = t + RG;
            if (tn < ntot) {
                int m2, n2;
                if (tn < nt1) { tile_decode8(tn, 22, m2, n2); nA = XB + (size_t)m2 * 256 * DM; nB = Bw + (size_t)n2 * 256 * DM; }
                else { const int t2 = tn - nt1; m2 = t2 & 3; n2 = t2 >> 2; nA = (const bf16_t*)(ws + O_MEMN) + (size_t)m2 * 256 * DM; nB = W + W_KV + (size_t)n2 * 256 * DM; }
            }
            if (t < nt1 && mt != rs_mt) { stage_rstd(ss, mt * 256, lds_all); rs_mt = mt; }
            gemm_kloop8<4>(cA, DM, cB, DM, DM, lds_all, acc, t == rbid, nA, nB);
            if (t < nt1) epi_swiglu(acc, mt * 256, nt * 256, (const float*)(lds_all + 131072 + 2048), (bf16_t*)(ws + O_H));
            else epi_kv(acc, mt * 256, nt * 256, (bf16_t*)(ws + O_KX), (bf16_t*)(ws + O_VXT));
        }
        if (q == 10) {
            const int hh = rbid;
            if (hh < 2 * (nt1 - ntot)) {
                const int t = ntot + (hh >> 1), half = hh & 1;
                int mt, nt; tile_decode8(t, 22, mt, nt);
                f32x4 ac2[8][2]; zero_acc8<2>(ac2);
                stage_rstd(ss, mt * 256, lds_all);
                gemm_kloop8<2>(XB + (size_t)mt * 256 * DM, DM, Bw + (size_t)(nt * 256 + half * 128) * DM, DM, DM, lds_all, ac2, true, nullptr, nullptr);
                epi_swiglu2(ac2, mt * 256, nt * 256 + half * 128, (const float*)(lds_all + 131072 + 2048), (bf16_t*)(ws + O_H));
            }
        }
    } break;
    case 1: case 11: {
        const bf16_t* Bw = W + (q == 1 ? W_1OUT : W_2OUT);
        float* sso = SSP(p, q == 1 ? (l * 5 + 1) : ((l + 1) * 5));
        for (int t = rbid; t < 64 * 4; t += RG) {
            int mt, nt; tile_decode8(t, 4, mt, nt);
            f32x4 acc[8][4]; zero_acc8<4>(acc);
            gemm_kloop8<4>((const bf16_t*)(ws + O_H) + (size_t)mt * 256 * FF, FF, Bw + (size_t)nt * 256 * FF, FF, FF, lds_all, acc, true, nullptr, nullptr);
            epi_resid(acc, mt * 256, nt * 256, X, XB, sso, 0.5f, dry);
        }
    } break;
    case 2: {
        int rs_mt = -1;
        for (int t = rbid; t < 64 * 23; t += RG) {
            int mt, nt; tile_decode8(t, 23, mt, nt);
            f32x4 acc[8][4]; zero_acc8<4>(acc);
            const bf16_t* nA = nullptr; const bf16_t* nB = nullptr;
            if (t + RG < 64 * 23) { int m2, n2; tile_decode8(t + RG, 23, m2, n2); nA = XB + (size_t)m2 * 256 * DM; nB = W + W_MIX + (size_t)n2 * 256 * DM; }
            if (mt != rs_mt) { stage_rstd(SSP(p, l * 5 + 1), mt * 256, lds_all); rs_mt = mt; }
            gemm_kloop8<4>(XB + (size_t)mt * 256 * DM, DM, W + W_MIX + (size_t)nt * 256 * DM, DM, DM, lds_all, acc, t == rbid, nA, nB);
            epi_mixin(acc, mt * 256, nt * 256, p, l, (const float*)(lds_all + 131072 + 2048));
        }
    } break;
    case 3: {
        int t = bid;
        for (; t < 512; t += G) gmlp_item(p, l, t, lds, lds_all + 131072 + 3072 + vb * 512, dry);
        lru_items<1>(p, l, t - 512, (2560 - t + G - 1) / G, G, lds, dry);
    } break;
    case 4: {
        float gq = fabsf(IN(p, 8)[l * 64 + lane]), gk = fabsf(IN(p, 9)[l * 64 + lane]);
#pragma unroll
        for (int o2 = 32; o2 > 0; o2 >>= 1) { gq = fmaxf(gq, __shfl_xor(gq, o2)); gk = fmaxf(gk, __shfl_xor(gk, o2)); }
        const float Bq = 8.f * gq * gk * 1.02f;
        const bool bounded = __builtin_amdgcn_readfirstlane(Bq <= 40.f ? 1 : 0) != 0;
        const float mfix = Bq * 1.4426950408889634f;
        int t = bid;
        for (; t < 1024; t += G) {
            {
                const int bk = t & 7, b = bk >> 1, kvh = bk & 1, g = (t >> 3) & 3, qb = t >> 5, head = kvh * 4 + g;
                bf16_t* Qp = (bf16_t*)(ws + O_Q) + (size_t)(b * 4096 + qb * 128) * 512 + head * 64;
                const bf16_t* Kp = (const bf16_t*)(ws + O_KB) + (size_t)(b * 4096) * 128 + kvh * 64;
                const bf16_t* Vp = (const bf16_t*)(ws + O_VT) + (size_t)((b * 2 + kvh) * 64) * 4096;
                __syncthreads();
                if (bounded) attn_item<64, 64, 2, false, true>(Qp, 512, Kp, 128, Vp, 4096, Qp, 512, 4096, 0.125f * 1.4426950408889634f, mfix, lds, dry);
                else attn_item<64, 64, 2, true, true>(Qp, 512, Kp, 128, Vp, 4096, Qp, 512, 4096, 0.125f * 1.4426950408889634f, 0.f, lds, dry);
            }
        }
        lru_items<3>(p, l, t - 1024, (3072 - t + G - 1) / G, G, lds, dry);
    } break;
    case 5: {
        const bf16_t* GT = (const bf16_t*)(ws + O_GATES);
        bf16_t* MG = (bf16_t*)(ws + O_MERGED);
        for (int t = rbid; t < 64 * 8; t += RG) {
            int mt, nt; tile_decode8(t, 8, mt, nt);
            LANE512
            f32x4 tot[8][2], ac2[8][2]; zero_acc8<2>(tot);
#pragma unroll 1
            for (int br = 0; br < 3; ++br) {
                const bf16_t* Ab = (const bf16_t*)(ws + (br == 0 ? O_Q : (br == 1 ? O_GU : O_GY)));
                zero_acc8<2>(ac2);
                const bf16_t* nA = nullptr; const bf16_t* nB = nullptr;
                if (br < 2) { nA = (const bf16_t*)(ws + (br == 0 ? O_GU : O_GY)) + (size_t)mt * 256 * 512; nB = W + W_AU + (size_t)(br + 1) * 524288 + (size_t)nt * 128 * 512; }
                else if (t + RG < 64 * 8) { int m2, n2; tile_decode8(t + RG, 8, m2, n2); nA = (const bf16_t*)(ws + O_Q) + (size_t)m2 * 256 * 512; nB = W + W_AU + (size_t)n2 * 128 * 512; }
                gemm_kloop8<2>(Ab + (size_t)mt * 256 * 512, 512, W + W_AU + (size_t)br * 524288 + (size_t)nt * 128 * 512, 512, 512, lds_all, ac2, t == rbid && br == 0, nA, nB);
#pragma unroll
                for (int a = 0; a < 8; ++a) {
                    const int row = mt * 256 + wr * 128 + a * 16 + l15;
#pragma unroll
                    for (int b2 = 0; b2 < 2; ++b2) {
                        const f32x4 g4 = unpk4(*(const uint2*)(GT + (size_t)row * 3072 + br * 1024 + nt * 128 + wc * 32 + b2 * 16 + quad * 4));
                        tot[a][b2] += g4 * ac2[a][b2];
                    }
                }
            }
#pragma unroll
            for (int a = 0; a < 8; ++a) {
                const int row = mt * 256 + wr * 128 + a * 16 + l15;
#pragma unroll
                for (int b2 = 0; b2 < 2; ++b2) *(uint2*)(MG + (size_t)row * DM + nt * 128 + wc * 32 + b2 * 16 + quad * 4) = pk4(tot[a][b2]);
            }
        }
    } break;
    case 6: case 9: {
        const bf16_t* Ab = (const bf16_t*)(ws + (q == 6 ? O_MERGED : O_OX));
        const bf16_t* Bw = W + (q == 6 ? W_MO : W_O);
        float* sso = SSP(p, l * 5 + (q == 6 ? 2 : 3));
        for (int t = rbid; t < 64 * 4; t += RG) {
            int mt, nt; tile_decode8(t, 4, mt, nt);
            f32x4 acc[8][4]; zero_acc8<4>(acc);
            gemm_kloop8<4>(Ab + (size_t)mt * 256 * DM, DM, Bw + (size_t)nt * 256 * DM, DM, DM, lds_all, acc, true, nullptr, nullptr);
            epi_resid(acc, mt * 256, nt * 256, X, XB, sso, 1.0f, dry);
        }
    } break;
    case 7: {
        const float* ss = SSP(p, l * 5 + 2);
        for (int t = rbid; t < 64 * 4; t += RG) {
            int mt, nt; tile_decode8(t, 4, mt, nt);
            f32x4 acc[8][4]; zero_acc8<4>(acc);
            stage_rstd(ss, mt * 256, lds_all);
            gemm_kloop8<4>(XB + (size_t)mt * 256 * DM, DM, W + W_Q + (size_t)nt * 256 * DM, DM, DM, lds_all, acc, true, nullptr, nullptr);
            epi_qx(acc, mt * 256, nt * 256, (const float*)(lds_all + 131072 + 2048), (bf16_t*)(ws + O_QX));
        }
    } break;
    case 8: {
        for (int t = bid; t < 1024; t += G) {
            const int bh = t & 15, b = bh >> 2, h = bh & 3, qt = t >> 4;
            const bf16_t* Qp = (const bf16_t*)(ws + O_QX) + (size_t)(b * 4096 + qt * 64) * 1024 + h * 256;
            const bf16_t* Kp = (const bf16_t*)(ws + O_KX) + (size_t)(b * 256) * 1024 + h * 256;
            const bf16_t* Vp = (const bf16_t*)(ws + O_VXT) + (size_t)((b * 4 + h) * 256) * 256;
            bf16_t* Op = (bf16_t*)(ws + O_OX) + (size_t)(b * 4096 + qt * 64) * 1024 + h * 256;
            __syncthreads();
            attn_item<256, 32, 1, true>(Qp, 1024, Kp, 1024, Vp, 256, Op, 1024, 256, 0.0625f * 1.4426950408889634f, 0.f, lds, dry);
        }
    } break;
    case 12: {
        if (l == 0) convert_weights(p, 1, lds, bid, G);
        else {
            const int gw = bid * 4 + (tid >> 6), nw = G * 4;
            const float* ss = SSP(p, 10);
            for (int row = gw; row < M; row += nw) {
                const float rstd = rsqrtf(ss_sum<16>(ss, row) * (1.f / 1024.f) + EPS);
#pragma unroll
                for (int i = 0; i < 4; ++i) {
                    const size_t off = (size_t)row * 1024 + i * 256 + lane * 4;
                    const f32x4 g = *(const f32x4*)(IN(p, 32) + i * 256 + lane * 4);
                    const f32x4 y = *(const f32x4*)(X + off) * rstd * g; if (!dry) *(f32x4*)(X + off) = y; else asm volatile("" :: "v"(y[0]), "v"(y[1]), "v"(y[2]), "v"(y[3]));
                }
            }
        }
    } break;
    }
}


#define XB_TMO      128
#define XB_XCNT(j)  (256  + 64 * (j))
#define XB_XSUB(j)  (1280 + 64 * (j))
#define XB_XGEN(j)  (2304 + 64 * (j))
#define XB_TOP      3328
#define XB_TOPGEN   3392
#define XCD_BAR_WORDS 3456
#define XB_SPIN_CAP (1u << 22)
DEVI unsigned xb_ld(unsigned* p)              { return __hip_atomic_load(p, __ATOMIC_RELAXED, __HIP_MEMORY_SCOPE_AGENT); }
DEVI unsigned xb_add(unsigned* p, unsigned v) { return __hip_atomic_fetch_add(p, v, __ATOMIC_RELAXED, __HIP_MEMORY_SCOPE_AGENT); }
DEVI unsigned xb_xcc_id() { return (unsigned)__builtin_amdgcn_s_getreg((3 << 11) | 20) & 0xFu; }
#define XB_SPIN(cond, bar) do { unsigned _sp = 0; while (cond) { __builtin_amdgcn_s_sleep(1); \
    if ((++_sp & 255u) == 0u) { if (xb_ld(&(bar)[XB_TMO])) break; if (_sp > XB_SPIN_CAP) { atomicAdd(&(bar)[XB_TMO], 1u); break; } } } } while (0)
DEVI void xcd_barrier_complete(unsigned* bar, unsigned x, unsigned& nloc, unsigned& nx) {
    const unsigned G = gridDim.x;
    unsigned sum, cnt, mine, sp = 0u;
    for (;;) {
        sum = 0u; cnt = 0u; mine = 0u;
#pragma unroll
        for (unsigned j = 0; j < 16; ++j) { const unsigned c = xb_ld(&bar[XB_XCNT(j)]); sum += c; cnt += (c > 0u) ? 1u : 0u; mine = (j == x) ? c : mine; }
        if (sum == G) break;
        __builtin_amdgcn_s_sleep(1);
        if ((++sp & 255u) == 0u) { if (xb_ld(&bar[XB_TMO])) break; if (sp > XB_SPIN_CAP) { atomicAdd(&bar[XB_TMO], 1u); break; } }
    }
    nloc = mine > 0u ? mine : 1u; nx = cnt > 0u ? cnt : 1u;
}
DEVI void xcd_barrier(unsigned* bar, LDS_AS volatile unsigned* st) {
    asm volatile("s_waitcnt vmcnt(0)" ::: "memory");
    __syncthreads();
    if (TID512() == 0) {
        __builtin_amdgcn_s_waitcnt(0);
        const unsigned x = xb_xcc_id();
        unsigned nloc = st[0], nx = st[1];
        if (nloc == 0u) { xcd_barrier_complete(bar, x, nloc, nx); st[0] = nloc; st[1] = nx; }
        const unsigned old = xb_add(&bar[XB_XSUB(x)], 1u);
        const unsigned gen = old / nloc;
        if (old + 1u == (gen + 1u) * nloc) {
            __builtin_amdgcn_fence(__ATOMIC_RELEASE, "agent");
            asm volatile("s_waitcnt vmcnt(0)" ::: "memory");
            const unsigned og = xb_add(&bar[XB_TOP], 1u);
            const unsigned tg = og / nx;
            if (og + 1u == (tg + 1u) * nx) xb_add(&bar[XB_TOPGEN], 1u);
            else XB_SPIN(xb_ld(&bar[XB_TOPGEN]) == tg, bar);
            __builtin_amdgcn_fence(__ATOMIC_ACQUIRE, "agent");
            xb_add(&bar[XB_XGEN(x)], 1u);
            asm volatile("s_waitcnt vmcnt(0)" ::: "memory");
        } else {
            XB_SPIN(xb_ld(&bar[XB_XGEN(x)]) == gen, bar);
            __builtin_amdgcn_fence(__ATOMIC_ACQUIRE, "agent");
            asm volatile("s_waitcnt vmcnt(0)" ::: "memory");
        }
    }
    __syncthreads();
}

__global__ void __launch_bounds__(512) mega(Params p) {
    __shared__ __attribute__((aligned(16))) char lds[131072 + 4096 + 64];
    cg::grid_group grid = cg::this_grid();
    if (TID512() == 0) { LDS_AS volatile unsigned* bst = (LDS_AS volatile unsigned*)(lds + 131072 + 4096); bst[0] = 0u; bst[1] = 0u; }
    __syncthreads();
    for (int ph = p.lo; ph < p.hi; ++ph) {
#ifdef REP_MASK
        { const int qq = ph == 0 ? 13 : (ph - 1) % 13; if ((REP_MASK >> qq) & 1) { run_phase(p, ph, lds, true); asm volatile("s_waitcnt vmcnt(0)" ::: "memory"); __syncthreads(); } }
#endif
        run_phase(p, ph, lds, false);
        if (ph + 1 < p.hi) {
            if (ph == p.lo) {
                asm volatile("s_waitcnt vmcnt(0)" ::: "memory");
                __syncthreads();
                if (TID512() < 64) { __builtin_amdgcn_fence(__ATOMIC_RELEASE, "agent"); asm volatile("s_waitcnt vmcnt(0)" ::: "memory"); }
                grid.sync();
                if (TID512() < 64) { __builtin_amdgcn_fence(__ATOMIC_ACQUIRE, "agent"); asm volatile("s_waitcnt vmcnt(0)" ::: "memory"); }
                if (TID512() == 0) (void)xb_add((unsigned*)(WS(p) + O_BAR) + XB_XCNT(xb_xcc_id()), 1u);
                __syncthreads();
            } else xcd_barrier((unsigned*)(WS(p) + O_BAR), (LDS_AS volatile unsigned*)(lds + 131072 + 4096));
        }
    }
}

extern "C" void kernel_launch(void* const* d_in, const int* in_sizes, int n_in, void* d_out, int out_size, void* d_ws, size_t ws_size, hipStream_t stream) {
    static int grid_blocks = 0;
    if (!grid_blocks) {
        int dev = 0, cus = 0, per_cu = 0;
        (void)hipGetDevice(&dev);
        (void)hipDeviceGetAttribute(&cus, hipDeviceAttributeMultiprocessorCount, dev);
        (void)hipOccupancyMaxActiveBlocksPerMultiprocessor(&per_cu, mega, 512, 0);
        if (per_cu < 1) fprintf(stderr, "kernel_launch: occupancy query says %d blocks/CU\n", per_cu);
        grid_blocks = cus;
        if (ws_size < O_END) fprintf(stderr, "kernel_launch: workspace too small: %zu < %zu\n", ws_size, (size_t)O_END);
    }
    Params p{};
    for (int i = 0; i < 33; ++i) p.in[i] = (const float*)d_in[i];
    p.out = (float*)d_out; p.ws = (unsigned char*)d_ws;
    p.lo = 0; p.hi = NPH;
    void* args[] = {&p};
    hipError_t e = hipLaunchCooperativeKernel((void*)mega, dim3(grid_blocks), dim3(512), args, 0, stream);
    if (e != hipSuccess) fprintf(stderr, "cooperative launch failed: %s (grid %d)\n", hipGetErrorString(e), grid_blocks);
}
```

```cpp
#include <hip/hip_runtime.h>
#include <hip/hip_cooperative_groups.h>
#include <cstdio>
namespace cg = cooperative_groups;

typedef unsigned short bf16_t;
typedef short bf16x8 __attribute__((ext_vector_type(8)));
typedef float f32x4 __attribute__((ext_vector_type(4)));
#define DEVI __device__ __forceinline__
#define LDS_AS __attribute__((address_space(3)))
DEVI int TID512() { int t = threadIdx.x; asm volatile("" : "+v"(t)); return t; }
DEVI int TIDX() { int t = threadIdx.x & 255; asm volatile("" : "+v"(t)); return t; }

constexpr int M = 16384, DM = 1024, FF = 2816;
constexpr float EPS = 1e-6f;
constexpr int NPH = 27;

constexpr size_t W_1IN = 0;
constexpr size_t W_1OUT = W_1IN + (size_t)5632 * 1024;
constexpr size_t W_MIX = W_1OUT + (size_t)1024 * 2816;
constexpr size_t W_AU = W_MIX + (size_t)5888 * 1024;
constexpr size_t W_GU = W_AU + (size_t)1024 * 512;
constexpr size_t W_LU = W_GU + (size_t)1024 * 512;
constexpr size_t W_MO = W_LU + (size_t)1024 * 512;
constexpr size_t W_Q = W_MO + (size_t)1024 * 1024;
constexpr size_t W_KV = W_Q + (size_t)1024 * 1024;
constexpr size_t W_O = W_KV + (size_t)2048 * 1024;
constexpr size_t W_2IN = W_O + (size_t)1024 * 1024;
constexpr size_t W_2OUT = W_2IN + (size_t)5632 * 1024;
constexpr size_t W_LWA = W_2OUT + (size_t)1024 * 2816;
constexpr size_t W_LWI = W_LWA + 65536;
constexpr size_t W_GWS = W_LWI + 65536;
constexpr size_t W_END = W_GWS + 65536;
constexpr size_t O_W = 0;
constexpr size_t O_XB = O_W + W_END * 2;
constexpr size_t O_R1 = O_XB + (size_t)M * DM * 2;
constexpr size_t O_H = O_R1;
constexpr size_t O_Q = O_R1;
constexpr size_t O_KB = O_Q + (size_t)M * 512 * 2;
constexpr size_t O_VT = O_KB + (size_t)M * 128 * 2;
constexpr size_t O_GU = O_VT + (size_t)M * 128 * 2;
constexpr size_t O_GVT = O_GU + (size_t)M * 512 * 2;
constexpr size_t O_LX = O_GVT + (size_t)M * 512 * 2;
constexpr size_t O_GY = O_LX + (size_t)M * 512 * 2;
constexpr size_t O_MERGED = O_GVT;
constexpr size_t O_R2 = O_R1 + (size_t)M * FF * 2;
constexpr size_t O_GATES = O_R2;
constexpr size_t O_QX = O_R2;
constexpr size_t O_OX = O_R2 + (size_t)M * DM * 2;
constexpr size_t O_MEMN = O_R2 + (size_t)M * DM * 4;
constexpr size_t O_KX = O_R2 + (size_t)M * 3072 * 2;
constexpr size_t O_VXT = O_KX + (size_t)1024 * 1024 * 2;
constexpr size_t O_AGG = O_VXT + (size_t)1024 * 1024 * 2;
constexpr size_t O_SS = O_AGG + (size_t)4 * 2 * 64 * 512 * 8;
constexpr size_t O_ROPE = O_SS + (size_t)11 * 16 * M * 4;
constexpr size_t O_BAR = O_ROPE + 8192;
constexpr size_t O_SP = O_BAR + 16384;
constexpr size_t O_END = O_SP + 4096;
static_assert(O_GY + (size_t)M * 512 * 2 == O_R2, "R1 mixer set must equal H");

struct Params { const float* in[33]; float* out; unsigned char* ws; int lo, hi; };
__device__ __forceinline__ const float* IN(const Params& p, int i) { const float* q = p.in[i]; asm volatile("" : "+s"(q)); return q; }
__device__ __forceinline__ unsigned char* WS(const Params& p) { unsigned char* w = p.ws; asm volatile("" : "+s"(w)); return w; }

DEVI unsigned f2bf(float f) { unsigned u = __float_as_uint(f); return (u + 0x7fffu + ((u >> 16) & 1u)) >> 16; }
DEVI float bf2f(unsigned h) { return __uint_as_float(h << 16); }
DEVI unsigned pk2(float a, float b) { unsigned r; asm("v_cvt_pk_bf16_f32 %0, %1, %2" : "=v"(r) : "v"(a), "v"(b)); return r; }
DEVI uint2 pk4(f32x4 v) { return make_uint2(pk2(v[0], v[1]), pk2(v[2], v[3])); }
DEVI f32x4 unpk4(uint2 u) { f32x4 r; r[0] = bf2f(u.x & 0xffffu); r[1] = bf2f(u.x >> 16); r[2] = bf2f(u.y & 0xffffu); r[3] = bf2f(u.y >> 16); return r; }
DEVI float sigm(float x) { return __builtin_amdgcn_rcpf(1.f + __expf(-x)); }
DEVI float gelu_t(float x) { float u = 0.7978845608028654f * (x + 0.044715f * x * x * x); return x * sigm(2.f * u); }
DEVI float wave_sum(float v) { for (int o = 32; o > 0; o >>= 1) v += __shfl_xor(v, o); return v; }
DEVI float* SSP(const Params& p, int slot) { return (float*)(WS(p) + O_SS) + (size_t)slot * 16 * M; }
template <int NP> DEVI float ss_sum(const float* ss, int row) { float s = 0.f;
#pragma unroll
    for (int i = 0; i < NP; ++i) s += ss[(size_t)i * M + row];
    return s; }

#define LANE512 const int tid5 = TID512(); const int lane = tid5 & 63, wave = tid5 >> 6, wr = wave >> 2, wc = wave & 3, l15 = lane & 15, quad = lane >> 4; (void)wr; (void)wc; (void)l15; (void)quad; (void)wave;
#define LANE_VARS const int tid_ = TIDX(); const int lane = tid_ & 63, wave = tid_ >> 6, wr = wave >> 1, wc = wave & 1, l15 = lane & 15, quad = lane >> 4; (void)wr; (void)wc; (void)l15; (void)quad; (void)wave;

template <int RB> DEVI int swz(int row, int c) {
    if (RB == 128) return row * 128 + ((c ^ ((row >> 1) & 7)) << 4);
    if (RB == 512) return row * 512 + ((c ^ (row & 15)) << 4);
    return row * 64 + ((c ^ ((row >> 2) & 3)) << 4);
}

template <int NTW>
DEVI void compute_ktile(const char* la, const char* lb, f32x4 (&acc)[4][NTW], int aoff0, int aoff1, int boff0, int boff1) {
#pragma unroll
    for (int ks = 0; ks < 2; ++ks) {
        bf16x8 af[4], bfr[NTW];
        const int ao = ks ? aoff1 : aoff0, bo = ks ? boff1 : boff0;
#pragma unroll
        for (int mt = 0; mt < 4; ++mt) af[mt] = *(const bf16x8*)(la + ao + mt * 2048);
#pragma unroll
        for (int nt = 0; nt < NTW; ++nt) bfr[nt] = *(const bf16x8*)(lb + bo + nt * 2048);
#pragma unroll
        for (int mt = 0; mt < 4; ++mt)
#pragma unroll
            for (int nt = 0; nt < NTW; ++nt) acc[mt][nt] = __builtin_amdgcn_mfma_f32_16x16x32_bf16(bfr[nt], af[mt], acc[mt][nt], 0, 0, 0);
    }
}
#define KT_OFFS(NTW) const int aoff0 = swz<128>(wr * 64 + l15, quad), aoff1 = swz<128>(wr * 64 + l15, 4 + quad), boff0 = swz<128>(wc * (NTW * 16) + l15, quad), boff1 = swz<128>(wc * (NTW * 16) + l15, 4 + quad);

template <int NTW>
DEVI void gemm_kloop(const bf16_t* __restrict__ A, int lda, const bf16_t* __restrict__ B, int ldb, int K, char* lds, f32x4 (&acc)[4][NTW]) {
    LANE_VARS
    KT_OFFS(NTW)
    const int tid = tid_;
    const int srow = tid >> 3, sc = tid & 7;
    const bf16_t* ga = A + (size_t)srow * lda + sc * 8;
    const bf16_t* gb = B + (size_t)srow * ldb + sc * 8;
    const int soff = swz<128>(srow, sc);
    uint4 ra0, ra1, ra2, ra3, rb0, rb1, rb2, rb3;
    rb2 = rb3 = make_uint4(0, 0, 0, 0);
    const int nk = K >> 6;
#define G_LOAD(k0) { ra0 = *(const uint4*)(ga + (k0)); ra1 = *(const uint4*)(ga + (size_t)32 * lda + (k0)); ra2 = *(const uint4*)(ga + (size_t)64 * lda + (k0)); ra3 = *(const uint4*)(ga + (size_t)96 * lda + (k0)); \
        rb0 = *(const uint4*)(gb + (k0)); rb1 = *(const uint4*)(gb + (size_t)32 * ldb + (k0)); \
        if (NTW == 4) { rb2 = *(const uint4*)(gb + (size_t)64 * ldb + (k0)); rb3 = *(const uint4*)(gb + (size_t)96 * ldb + (k0)); } }
#define G_STORE(ls) { *(uint4*)((ls) + soff) = ra0; *(uint4*)((ls) + soff + 4096) = ra1; *(uint4*)((ls) + soff + 8192) = ra2; *(uint4*)((ls) + soff + 12288) = ra3; \
        *(uint4*)((ls) + 16384 + soff) = rb0; *(uint4*)((ls) + 16384 + soff + 4096) = rb1; \
        if (NTW == 4) { *(uint4*)((ls) + 16384 + soff + 8192) = rb2; *(uint4*)((ls) + 16384 + soff + 12288) = rb3; } }
    G_LOAD(0)
    __syncthreads();
    G_STORE(lds)
    __syncthreads();
    for (int kt = 0; kt < nk; ++kt) {
        const bool more = (kt + 1 < nk);
        if (more) { const int k0 = (kt + 1) << 6; G_LOAD(k0) }
        const char* la = lds + (kt & 1) * 32768;
        compute_ktile<NTW>(la, la + 16384, acc, aoff0, aoff1, boff0, boff1);
        if (more) { char* ls = lds + ((kt + 1) & 1) * 32768; G_STORE(ls) }
        __syncthreads();
    }
#undef G_LOAD
#undef G_STORE
}

template <int NTW>
DEVI void compute_tile8(const char* la, const char* lb, f32x4 (&acc)[8][NTW], int aoff0, int aoff1, int boff0, int boff1) {
    if (NTW == 2) {
#pragma unroll
        for (int ks = 0; ks < 2; ++ks) {
            const int ao = ks ? aoff1 : aoff0, bo = ks ? boff1 : boff0;
            bf16x8 bfr[NTW];
#pragma unroll
            for (int nt = 0; nt < NTW; ++nt) bfr[nt] = *(const bf16x8*)(lb + bo + nt * 2048);
#pragma unroll
            for (int hh = 0; hh < 2; ++hh) {
                bf16x8 af[4];
#pragma unroll
                for (int mt = 0; mt < 4; ++mt) af[mt] = *(const bf16x8*)(la + ao + (hh * 4 + mt) * 2048);
                __builtin_amdgcn_sched_barrier(0);
#pragma unroll
                for (int mt = 0; mt < 4; ++mt)
#pragma unroll
                    for (int nt = 0; nt < NTW; ++nt) acc[hh * 4 + mt][nt] = __builtin_amdgcn_mfma_f32_16x16x32_bf16(bfr[nt], af[mt], acc[hh * 4 + mt][nt], 0, 0, 0);
                __builtin_amdgcn_sched_barrier(0);
            }
        }
        return;
    }
    bf16x8 b0[NTW], b1[NTW], a0[4], a1[4];
#define LDF(p) (*(const bf16x8*)(p))
#define MM16(HB, BF, AF) _Pragma("unroll") for (int mt = 0; mt < 4; ++mt) _Pragma("unroll") for (int nt = 0; nt < NTW; ++nt) \
        acc[HB + mt][nt] = __builtin_amdgcn_mfma_f32_16x16x32_bf16(BF[nt], AF[mt], acc[HB + mt][nt], 0, 0, 0);
#define SB __builtin_amdgcn_sched_barrier(0);
#pragma unroll
    for (int nt = 0; nt < NTW; ++nt) b0[nt] = LDF(lb + boff0 + nt * 2048);
#pragma unroll
    for (int mt = 0; mt < 4; ++mt) a0[mt] = LDF(la + aoff0 + mt * 2048);
#pragma unroll
    for (int mt = 0; mt < 4; ++mt) a1[mt] = LDF(la + aoff0 + (4 + mt) * 2048);
    SB MM16(0, b0, a0) SB
#pragma unroll
    for (int nt = 0; nt < NTW; ++nt) b1[nt] = LDF(lb + boff1 + nt * 2048);
#pragma unroll
    for (int mt = 0; mt < 4; ++mt) a0[mt] = LDF(la + aoff1 + mt * 2048);
    SB MM16(4, b0, a1) SB
#pragma unroll
    for (int mt = 0; mt < 4; ++mt) a1[mt] = LDF(la + aoff1 + (4 + mt) * 2048);
    SB MM16(0, b1, a0) SB
    MM16(4, b1, a1)
#undef LDF
#undef MM16
#undef SB
}
template <int NTW>
DEVI void gemm_kloop8(const bf16_t* __restrict__ A, int lda, const bf16_t* __restrict__ B, int ldb, int K, char* lds, f32x4 (&acc)[8][NTW], bool first, const bf16_t* nA, const bf16_t* nB) {
    LANE512
    const int aoff0 = swz<128>(wr * 128 + l15, quad), aoff1 = swz<128>(wr * 128 + l15, 4 + quad);
    const int boff0 = swz<128>(wc * (NTW * 16) + l15, quad), boff1 = swz<128>(wc * (NTW * 16) + l15, 4 + quad);
    const int srow = tid5 >> 3, sc = (tid5 & 7) ^ ((srow >> 1) & 7);
    const bf16_t* ga = A + (size_t)srow * lda + sc * 8;
    const bf16_t* gb = B + (size_t)srow * ldb + sc * 8;
    const int wbase = __builtin_amdgcn_readfirstlane(wave) * 1024;
    const int nk = K >> 6;
#define GLDS1(gp, lp) __builtin_amdgcn_global_load_lds((const unsigned*)(gp), (LDS_AS unsigned*)(lp), 16, 0, 0)
#define G_ISSUE(ls, k0) { char* l_ = (ls) + wbase; \
        GLDS1(ga + (k0), l_); GLDS1(ga + (size_t)64 * lda + (k0), l_ + 8192); GLDS1(ga + (size_t)128 * lda + (k0), l_ + 16384); GLDS1(ga + (size_t)192 * lda + (k0), l_ + 24576); \
        GLDS1(gb + (k0), l_ + 32768); GLDS1(gb + (size_t)64 * ldb + (k0), l_ + 32768 + 8192); \
        if (NTW == 4) { GLDS1(gb + (size_t)128 * ldb + (k0), l_ + 32768 + 16384); GLDS1(gb + (size_t)192 * ldb + (k0), l_ + 32768 + 24576); } }
    if (first) { __syncthreads();
        G_ISSUE(lds, 0) }
    asm volatile("s_waitcnt vmcnt(0)" ::: "memory");
    __syncthreads();
    for (int kt = 0; kt < nk; ++kt) {
        if (kt + 1 < nk) { char* ls = lds + ((kt + 1) & 1) * 65536; const int k0 = (kt + 1) << 6; G_ISSUE(ls, k0) }
        else if (nA) { ga = nA + (size_t)srow * lda + sc * 8; gb = nB + (size_t)srow * ldb + sc * 8; G_ISSUE(lds, 0) }
        __builtin_amdgcn_sched_barrier(0);
        const char* la = lds + (kt & 1) * 65536;
        compute_tile8<NTW>(la, la + 32768, acc, aoff0, aoff1, boff0, boff1);
        if (kt + 1 < nk) {
            asm volatile("s_waitcnt vmcnt(0)" ::: "memory");
            __syncthreads();
        }
    }
#undef G_ISSUE
#undef GLDS1
}
template <int NTW>
DEVI void zero_acc8(f32x4 (&acc)[8][NTW]) {
#pragma unroll
    for (int a = 0; a < 8; ++a)
#pragma unroll
        for (int b = 0; b < NTW; ++b) acc[a][b] = (f32x4){0.f, 0.f, 0.f, 0.f};
}
DEVI void tile_decode8(int t, int NT, int& mt, int& nt) { const int xcd = t & 7, s = t >> 3, mi = s & 3, q = s >> 2; nt = q % NT; const int mg = q / NT; mt = xcd * 8 + mg * 4 + mi; }

template <int NTW>
DEVI void zero_acc(f32x4 (&acc)[4][NTW]) {
#pragma unroll
    for (int a = 0; a < 4; ++a)
#pragma unroll
        for (int b = 0; b < NTW; ++b) acc[a][b] = (f32x4){0.f, 0.f, 0.f, 0.f};
}
DEVI void tile_decode(int t, int NT, int& mt, int& nt) { const int xcd = t & 7, s = t >> 3, mi = s & 3, q = s >> 2; nt = q % NT; const int mg = q / NT; mt = ((mg << 3) + xcd) * 4 + mi; }


DEVI void stage_rstd(const float* ss, int m0, char* lds_all) {
    float* part = (float*)(lds_all + 131072); float* rs = part + 512;
    const int t5 = TID512(), r = t5 & 255, half = t5 >> 8;
    float sacc = 0.f;
#pragma unroll
    for (int i = 0; i < 8; ++i) sacc += ss[(size_t)(half * 8 + i) * M + m0 + r];
    __syncthreads();
    part[t5] = sacc;
    __syncthreads();
    if (t5 < 256) rs[t5] = rsqrtf((part[t5] + part[t5 + 256]) * (1.f / 1024.f) + EPS);
}
DEVI void epi_swiglu(f32x4 (&acc)[8][4], int m0, int n0, const float* rs, bf16_t* H) {
    LANE512
#pragma unroll
    for (int mt = 0; mt < 8; ++mt) {
        const int row = m0 + wr * 128 + mt * 16 + l15;
        const float rstd = rs[wr * 128 + mt * 16 + l15];
#pragma unroll
        for (int pp = 0; pp < 2; ++pp) {
            f32x4 a = acc[mt][2 * pp] * rstd, b = acc[mt][2 * pp + 1] * rstd, h;
#pragma unroll
            for (int j = 0; j < 4; ++j) h[j] = a[j] * sigm(a[j]) * b[j];
            *(uint2*)(H + (size_t)row * FF + (n0 >> 1) + wc * 32 + pp * 16 + quad * 4) = pk4(h);
        }
    }
}
DEVI void epi_resid(f32x4 (&acc)[8][4], int m0, int n0, float* X, bf16_t* XB, float* ssout, float scale, bool dry) {
    LANE512
#pragma unroll
    for (int mt = 0; mt < 8; ++mt) {
        const int row = m0 + wr * 128 + mt * 16 + l15;
        float part = 0.f;
#pragma unroll
        for (int nt = 0; nt < 4; ++nt) {
            const size_t off = (size_t)row * DM + n0 + wc * 64 + nt * 16 + quad * 4;
            f32x4 x = *(const f32x4*)(X + off);
            x += acc[mt][nt] * scale;
            if (!dry) { *(f32x4*)(X + off) = x; *(uint2*)(XB + off) = pk4(x); }
            part += x[0] * x[0] + x[1] * x[1] + x[2] * x[2] + x[3] * x[3];
        }
        part += __shfl_xor(part, 16); part += __shfl_xor(part, 32);
        if (quad == 0 && !dry) ssout[(size_t)((n0 >> 6) + wc) * M + row] = part;
    }
}
DEVI void epi_qx(f32x4 (&acc)[8][4], int m0, int n0, const float* rs, bf16_t* QX) {
    LANE512
#pragma unroll
    for (int mt = 0; mt < 8; ++mt) {
        const int row = m0 + wr * 128 + mt * 16 + l15;
        const float rstd = rs[wr * 128 + mt * 16 + l15];
#pragma unroll
        for (int nt = 0; nt < 4; ++nt) *(uint2*)(QX + (size_t)row * DM + n0 + wc * 64 + nt * 16 + quad * 4) = pk4(acc[mt][nt] * rstd);
    }
}
DEVI void epi_kv(f32x4 (&acc)[8][4], int m0, int n0, bf16_t* KX, bf16_t* VXT) {
    LANE512
    const int cb = n0 + wc * 64;
#pragma unroll
    for (int mt = 0; mt < 8; ++mt) {
        const int row = m0 + wr * 128 + mt * 16 + l15;
        if (cb < 1024) {
#pragma unroll
            for (int nt = 0; nt < 4; ++nt) *(uint2*)(KX + (size_t)row * 1024 + cb + nt * 16 + quad * 4) = pk4(acc[mt][nt]);
        } else {
            const int c2 = cb - 1024, h = c2 >> 8, d0 = c2 & 255, b = row >> 8, mm = row & 255;
#pragma unroll
            for (int nt = 0; nt < 4; ++nt)
#pragma unroll
                for (int j = 0; j < 4; ++j) VXT[((size_t)((b * 4 + h) * 256 + d0 + nt * 16 + quad * 4 + j)) * 256 + mm] = (bf16_t)f2bf(acc[mt][nt][j]);
        }
    }
}
DEVI void epi_mixin(f32x4 (&acc)[8][4], int m0, int n0, const Params& p, int l, const float* rs) {
    LANE512
    unsigned char* ws = WS(p);
    const int cb = n0 + wc * 64;
#define MIX_ROWS_BEGIN _Pragma("unroll") for (int mt = 0; mt < 8; ++mt) { const int row = m0 + wr * 128 + mt * 16 + l15; \
        const float rstd = rs[wr * 128 + mt * 16 + l15]; \
        f32x4 v0 = acc[mt][0] * rstd, v1 = acc[mt][1] * rstd, v2 = acc[mt][2] * rstd, v3 = acc[mt][3] * rstd;
#define MIX_ROWS_END }
    if (cb < 640) {
        const float* gn = (cb < 512 ? IN(p, 8) : IN(p, 9)) + l * 64;
        const f32x4 g0 = *(const f32x4*)(gn + quad * 4), g1 = *(const f32x4*)(gn + 16 + quad * 4), g2 = *(const f32x4*)(gn + 32 + quad * 4), g3 = *(const f32x4*)(gn + 48 + quad * 4);
        const float* cosT = (const float*)(ws + O_ROPE); const float* sinT = cosT + 1024;
        MIX_ROWS_BEGIN
            float s2 = v0[0] * v0[0] + v0[1] * v0[1] + v0[2] * v0[2] + v0[3] * v0[3] + v1[0] * v1[0] + v1[1] * v1[1] + v1[2] * v1[2] + v1[3] * v1[3]
                     + v2[0] * v2[0] + v2[1] * v2[1] + v2[2] * v2[2] + v2[3] * v2[3] + v3[0] * v3[0] + v3[1] * v3[1] + v3[2] * v3[2] + v3[3] * v3[3];
            s2 += __shfl_xor(s2, 16); s2 += __shfl_xor(s2, 32);
            const float rn = rsqrtf(s2 * (1.f / 64.f) + EPS);
            v0 = v0 * rn * g0; v1 = v1 * rn * g1; v2 = v2 * rn * g2; v3 = v3 * rn * g3;
            const int t = row & 4095, pr = t >> 6, pc = t & 63;
            const f32x4 cr = *(const f32x4*)(cosT + pr * 16 + quad * 4), sr = *(const f32x4*)(sinT + pr * 16 + quad * 4);
            const f32x4 cc = *(const f32x4*)(cosT + pc * 16 + quad * 4), sc2 = *(const f32x4*)(sinT + pc * 16 + quad * 4);
            const f32x4 o0 = v0 * cr - v1 * sr, o1 = v1 * cr + v0 * sr, o2 = v2 * cc - v3 * sc2, o3 = v3 * cc + v2 * sc2;
            bf16_t* dst = (cb < 512) ? ((bf16_t*)(ws + O_Q) + (size_t)row * 512 + cb) : ((bf16_t*)(ws + O_KB) + (size_t)row * 128 + (cb - 512));
            *(uint2*)(dst + 0 + quad * 4) = pk4(o0); *(uint2*)(dst + 16 + quad * 4) = pk4(o1);
            *(uint2*)(dst + 32 + quad * 4) = pk4(o2); *(uint2*)(dst + 48 + quad * 4) = pk4(o3);
        MIX_ROWS_END
    } else if (cb < 768) {
        const int kvh = (cb - 640) >> 6;
        bf16_t* VT = (bf16_t*)(ws + O_VT);
        MIX_ROWS_BEGIN
            const int b = row >> 12, t = row & 4095;
            bf16_t* vp = VT + ((size_t)((b * 2 + kvh) * 64 + quad * 4)) * 4096 + t;
#pragma unroll
            for (int j = 0; j < 4; ++j) {
                vp[(size_t)(j) * 4096] = (bf16_t)f2bf(v0[j]); vp[(size_t)(16 + j) * 4096] = (bf16_t)f2bf(v1[j]);
                vp[(size_t)(32 + j) * 4096] = (bf16_t)f2bf(v2[j]); vp[(size_t)(48 + j) * 4096] = (bf16_t)f2bf(v3[j]);
            }
        MIX_ROWS_END
    } else if (cb < 1280 || (cb >= 2304 && cb < 2816)) {
        bf16_t* base = (cb < 1280) ? ((bf16_t*)(ws + O_GU) + (cb - 768)) : ((bf16_t*)(ws + O_GY) + (cb - 2304));
        MIX_ROWS_BEGIN
            bf16_t* dp = base + (size_t)row * 512 + quad * 4;
            f32x4 a, b, c, d;
#pragma unroll
            for (int j = 0; j < 4; ++j) { a[j] = gelu_t(v0[j]); b[j] = gelu_t(v1[j]); c[j] = gelu_t(v2[j]); d[j] = gelu_t(v3[j]); }
            *(uint2*)(dp) = pk4(a); *(uint2*)(dp + 16) = pk4(b); *(uint2*)(dp + 32) = pk4(c); *(uint2*)(dp + 48) = pk4(d);
        MIX_ROWS_END
    } else if (cb < 1792) {
        bf16_t* GVT = (bf16_t*)(ws + O_GVT);
        float* ssg = SSP(p, l * 5 + 4) + (size_t)((cb - 1280) >> 6) * M;
        MIX_ROWS_BEGIN
            bf16_t* gp = GVT + ((size_t)((row >> 7) * 512 + (cb - 1280) + quad * 4)) * 128 + (row & 127);
            float s2 = 0.f;
#pragma unroll
            for (int j = 0; j < 4; ++j) {
                const float a = gelu_t(v0[j]), b = gelu_t(v1[j]), c = gelu_t(v2[j]), d = gelu_t(v3[j]);
                s2 += a * a + b * b + c * c + d * d;
                gp[(size_t)j * 128] = (bf16_t)f2bf(a); gp[(size_t)(16 + j) * 128] = (bf16_t)f2bf(b); gp[(size_t)(32 + j) * 128] = (bf16_t)f2bf(c); gp[(size_t)(48 + j) * 128] = (bf16_t)f2bf(d);
            }
            s2 += __shfl_xor(s2, 16); s2 += __shfl_xor(s2, 32);
            if (quad == 0) ssg[row] = s2;
        MIX_ROWS_END
    } else if (cb < 2304) {
        bf16_t* LX = (bf16_t*)(ws + O_LX) + (cb - 1792);
        MIX_ROWS_BEGIN
            bf16_t* dp = LX + (size_t)row * 512 + quad * 4;
            *(uint2*)(dp) = pk4(v0); *(uint2*)(dp + 16) = pk4(v1); *(uint2*)(dp + 32) = pk4(v2); *(uint2*)(dp + 48) = pk4(v3);
        MIX_ROWS_END
    } else {
        bf16_t* GT = (bf16_t*)(ws + O_GATES) + (cb - 2816);
        const float* bg = IN(p, 7) + (size_t)l * 3072 + (cb - 2816) + quad * 4;
        const f32x4 b0 = *(const f32x4*)(bg), b1 = *(const f32x4*)(bg + 16), b2 = *(const f32x4*)(bg + 32), b3 = *(const f32x4*)(bg + 48);
        MIX_ROWS_BEGIN
            bf16_t* dp = GT + (size_t)row * 3072 + quad * 4;
            f32x4 a, b, c, d;
#pragma unroll
            for (int j = 0; j < 4; ++j) { a[j] = sigm(v0[j] + b0[j]); b[j] = sigm(v1[j] + b1[j]); c[j] = sigm(v2[j] + b2[j]); d[j] = sigm(v3[j] + b3[j]); }
            *(uint2*)(dp) = pk4(a); *(uint2*)(dp + 16) = pk4(b); *(uint2*)(dp + 32) = pk4(c); *(uint2*)(dp + 48) = pk4(d);
        MIX_ROWS_END
    }
#undef MIX_ROWS_BEGIN
#undef MIX_ROWS_END
}

template <int D, int KT, int MT, bool ONLINE, bool DMA = false>
DEVI void attn_item(const bf16_t* __restrict__ Q, int ldq, const bf16_t* __restrict__ Kp, int ldk, const bf16_t* __restrict__ Vt, int ldv,
                    bf16_t* O, int ldo, int nkeys, float sc, float mfix, char* lds, bool dry) {
    LANE_VARS
    constexpr int NT = KT / 16, KS = D / 32, NTD = D / 16, KS2 = KT / 32;
    constexpr int KRB = D * 2, VRB = KT * 2, KBYTES = KT * D * 2, NCH = KT * D / 8 / 256, PB = MT * 16 * KT * 2;
    constexpr int KCPR = D / 8, VCPR = KT / 8;
    char* lK = lds; char* lV = lds + KBYTES; char* lP = lds + (DMA ? 32768 : 2 * KBYTES) + wave * PB;
    bf16x8 qf[MT][KS];
#pragma unroll
    for (int mt = 0; mt < MT; ++mt)
#pragma unroll
        for (int ks = 0; ks < KS; ++ks) qf[mt][ks] = *(const bf16x8*)(Q + (size_t)((wave * MT + mt) * 16 + l15) * ldq + ks * 32 + quad * 8);
    f32x4 o[MT][NTD];
    float mrow[MT], lrow[MT];
#pragma unroll
    for (int mt = 0; mt < MT; ++mt) { mrow[mt] = -1e30f; lrow[mt] = 0.f;
#pragma unroll
        for (int n = 0; n < NTD; ++n) o[mt][n] = (f32x4){0.f, 0.f, 0.f, 0.f}; }
    uint4 rk0, rk1, rk2, rk3, rv0, rv1, rv2, rv3;
    rk2 = rk3 = rv2 = rv3 = make_uint4(0, 0, 0, 0);
    const int tid = TIDX();
#define ATT_LD1(i, key0) if (NCH > i) { const int id = i * 256 + tid; \
        rk##i = *(const uint4*)(Kp + (size_t)((key0) + id / KCPR) * ldk + (id % KCPR) * 8); \
        rv##i = *(const uint4*)(Vt + (size_t)(id / VCPR) * ldv + (key0) + (id % VCPR) * 8); }
#define ATT_LOAD(key0) ATT_LD1(0, key0) ATT_LD1(1, key0) ATT_LD1(2, key0) ATT_LD1(3, key0)
#define ATT_ST1(i) if (NCH > i) { const int id = i * 256 + tid; \
        *(uint4*)(lK + swz<KRB>(id / KCPR, id % KCPR)) = rk##i; *(uint4*)(lV + swz<VRB>(id / VCPR, id % VCPR)) = rv##i; }
    const int drow = wave * 8 + (lane >> 3), dch = ((lane & 7) ^ ((drow >> 1) & 7)) * 8;
    const int wv1k = __builtin_amdgcn_readfirstlane(wave) * 1024;
#define ATT_DMA(key0, buf) { char* b_ = lds + (buf) * 16384 + wv1k; \
        __builtin_amdgcn_global_load_lds((const unsigned*)(Kp + (size_t)((key0) + drow) * ldk + dch), (LDS_AS unsigned*)(b_), 16, 0, 0); \
        __builtin_amdgcn_global_load_lds((const unsigned*)(Kp + (size_t)((key0) + 32 + drow) * ldk + dch), (LDS_AS unsigned*)(b_ + 4096), 16, 0, 0); \
        __builtin_amdgcn_global_load_lds((const unsigned*)(Vt + (size_t)drow * ldv + (key0) + dch), (LDS_AS unsigned*)(b_ + 8192), 16, 0, 0); \
        __builtin_amdgcn_global_load_lds((const unsigned*)(Vt + (size_t)(32 + drow) * ldv + (key0) + dch), (LDS_AS unsigned*)(b_ + 8192 + 4096), 16, 0, 0); }
    if (DMA) { ATT_DMA(0, 0) } else { ATT_LOAD(0) }
    const int ntile = nkeys / KT;
    for (int kt = 0; kt < ntile; ++kt) {
        if (DMA) {
            asm volatile("s_waitcnt vmcnt(0)" ::: "memory");
            __syncthreads();
            if (kt + 1 < ntile) { const int key0 = (kt + 1) * KT; ATT_DMA(key0, (kt + 1) & 1) }
            lK = lds + (kt & 1) * 16384; lV = lK + 8192;
        } else {
        __syncthreads();
        ATT_ST1(0) ATT_ST1(1) ATT_ST1(2) ATT_ST1(3)
        __syncthreads();
        if (kt + 1 < ntile) { const int key0 = (kt + 1) * KT; ATT_LOAD(key0) }
        }
        __builtin_amdgcn_sched_barrier(0);
        f32x4 s[MT][NT];
#pragma unroll
        for (int mt = 0; mt < MT; ++mt)
#pragma unroll
            for (int nt = 0; nt < NT; ++nt) s[mt][nt] = (f32x4){0.f, 0.f, 0.f, 0.f};
        constexpr bool WIDE = (D == 64);
        bf16x8 vfa[WIDE ? KS2 : 1][WIDE ? NTD : 1];
        if (WIDE) {
            bf16x8 kfa[KS][NT];
#pragma unroll
            for (int ks = 0; ks < KS; ++ks)
#pragma unroll
                for (int nt = 0; nt < NT; ++nt) kfa[ks][nt] = *(const bf16x8*)(lK + swz<KRB>(nt * 16 + l15, ks * 4 + quad));
            __builtin_amdgcn_sched_barrier(0);
#pragma unroll
            for (int ks = 0; ks < KS; ++ks)
#pragma unroll
                for (int nt = 0; nt < NT; ++nt)
#pragma unroll
                    for (int mt = 0; mt < MT; ++mt) s[mt][nt] = __builtin_amdgcn_mfma_f32_16x16x32_bf16(kfa[ks][nt], qf[mt][ks], s[mt][nt], 0, 0, 0);
            __builtin_amdgcn_sched_barrier(0);
#pragma unroll
            for (int k2 = 0; k2 < KS2; ++k2)
#pragma unroll
                for (int n = 0; n < NTD; ++n) vfa[k2][n] = *(const bf16x8*)(lV + swz<VRB>(n * 16 + l15, k2 * 4 + quad));
            __builtin_amdgcn_sched_barrier(0);
        } else {
#pragma unroll
        for (int ks = 0; ks < KS; ++ks) {
            bf16x8 kf[NT];
#pragma unroll
            for (int nt = 0; nt < NT; ++nt) kf[nt] = *(const bf16x8*)(lK + swz<KRB>(nt * 16 + l15, ks * 4 + quad));
            __builtin_amdgcn_sched_barrier(0);
#pragma unroll
            for (int nt = 0; nt < NT; ++nt)
#pragma unroll
                for (int mt = 0; mt < MT; ++mt) s[mt][nt] = __builtin_amdgcn_mfma_f32_16x16x32_bf16(kf[nt], qf[mt][ks], s[mt][nt], 0, 0, 0);
            __builtin_amdgcn_sched_barrier(0);
        }
        }
#pragma unroll
        for (int mt = 0; mt < MT; ++mt) {
            if (!ONLINE) {
                f32x4 rs4 = (f32x4){0.f, 0.f, 0.f, 0.f};
#pragma unroll
                for (int nt = 0; nt < NT; ++nt) {
                    const f32x4 e = s[mt][nt] * sc - mfix;
                    f32x4 pv;
#pragma unroll
                    for (int j = 0; j < 4; ++j) pv[j] = __builtin_amdgcn_exp2f(e[j]);
                    rs4 += pv;
                    *(uint2*)(lP + swz<VRB>(mt * 16 + l15, nt * 2 + (quad >> 1)) + (quad & 1) * 8) = pk4(pv);
                }
                lrow[mt] += (rs4[0] + rs4[1]) + (rs4[2] + rs4[3]);
                continue;
            }
            float mx = -1e30f;
#pragma unroll
            for (int nt = 0; nt < NT; ++nt) mx = fmaxf(mx, fmaxf(fmaxf(s[mt][nt][0], s[mt][nt][1]), fmaxf(s[mt][nt][2], s[mt][nt][3])));
            mx = fmaxf(mx, __shfl_xor(mx, 16)); mx = fmaxf(mx, __shfl_xor(mx, 32));
            const float mnew = fmaxf(mrow[mt], mx * sc);
            const float alpha = __builtin_amdgcn_exp2f(mrow[mt] - mnew);
            mrow[mt] = mnew;
            float rs = 0.f;
#pragma unroll
            for (int nt = 0; nt < NT; ++nt) {
                f32x4 pv;
#pragma unroll
                for (int j = 0; j < 4; ++j) { pv[j] = __builtin_amdgcn_exp2f(s[mt][nt][j] * sc - mnew); rs += pv[j]; }
                *(uint2*)(lP + swz<VRB>(mt * 16 + l15, nt * 2 + (quad >> 1)) + (quad & 1) * 8) = pk4(pv);
            }
            lrow[mt] = lrow[mt] * alpha + rs;
#pragma unroll
            for (int n = 0; n < NTD; ++n) o[mt][n] *= alpha;
        }
        asm volatile("" ::: "memory");
        if (WIDE) {
            bf16x8 pfa[KS2][MT];
#pragma unroll
            for (int k2 = 0; k2 < KS2; ++k2)
#pragma unroll
                for (int mt = 0; mt < MT; ++mt) pfa[k2][mt] = *(const bf16x8*)(lP + swz<VRB>(mt * 16 + l15, k2 * 4 + quad));
            __builtin_amdgcn_sched_barrier(0);
#pragma unroll
            for (int k2 = 0; k2 < KS2; ++k2)
#pragma unroll
                for (int n = 0; n < NTD; ++n)
#pragma unroll
                    for (int mt = 0; mt < MT; ++mt) o[mt][n] = __builtin_amdgcn_mfma_f32_16x16x32_bf16(vfa[k2][n], pfa[k2][mt], o[mt][n], 0, 0, 0);
            __builtin_amdgcn_sched_barrier(0);
        } else
#pragma unroll
        for (int k2 = 0; k2 < KS2; ++k2) {
            bf16x8 pf[MT];
#pragma unroll
            for (int mt = 0; mt < MT; ++mt) pf[mt] = *(const bf16x8*)(lP + swz<VRB>(mt * 16 + l15, k2 * 4 + quad));
#pragma unroll
            for (int n0 = 0; n0 < NTD; n0 += 4) {
                bf16x8 vf[4];
#pragma unroll
                for (int n = 0; n < 4; ++n) vf[n] = *(const bf16x8*)(lV + swz<VRB>((n0 + n) * 16 + l15, k2 * 4 + quad));
                __builtin_amdgcn_sched_barrier(0);
#pragma unroll
                for (int n = 0; n < 4; ++n)
#pragma unroll
                    for (int mt = 0; mt < MT; ++mt) o[mt][n0 + n] = __builtin_amdgcn_mfma_f32_16x16x32_bf16(vf[n], pf[mt], o[mt][n0 + n], 0, 0, 0);
                __builtin_amdgcn_sched_barrier(0);
            }
        }
    }
#undef ATT_LOAD
#undef ATT_LD1
#undef ATT_ST1
#undef ATT_DMA
#pragma unroll
    for (int mt = 0; mt < MT; ++mt) {
        float l = lrow[mt]; l += __shfl_xor(l, 16); l += __shfl_xor(l, 32);
        const float inv = 1.f / l;
        bf16_t* op = O + (size_t)((wave * MT + mt) * 16 + l15) * ldo + quad * 4;
#pragma unroll
        for (int n = 0; n < NTD; ++n) { const uint2 w = pk4(o[mt][n] * inv); if (!dry) *(uint2*)(op + n * 16) = w; else asm volatile("" :: "v"(w.x), "v"(w.y)); }
    }
}

DEVI void gmlp_item(const Params& p, int l, int item, char* lds, char* rs_lds, bool dry) {
    LANE_VARS
    const int tid = TIDX(), g = item & 3, bc = item >> 2, row0 = bc * 128;
    unsigned char* wsb = WS(p);
    const bf16_t* WSg = (const bf16_t*)(wsb + O_W) + W_GWS + (size_t)g * 16384;
    const bf16_t* GVT = (const bf16_t*)(wsb + O_GVT) + ((size_t)bc * 512 + g * 128) * 128;
    const float* ssg = SSP(p, l * 5 + 4) + row0;
    const float* gain = IN(p, 11) + l * 512 + g * 128;
    const int srow = tid >> 3, sc = tid & 7;
    float* rsl = (float*)rs_lds;
    __syncthreads();
    if (tid < 128) rsl[tid] = rsqrtf(ss_sum<8>(ssg, tid) * (1.f / 512.f) + EPS);
    __syncthreads();
#pragma unroll
    for (int kt = 0; kt < 2; ++kt) {
        float rs[8];
#pragma unroll
        for (int e = 0; e < 8; ++e) rs[e] = rsl[kt * 64 + sc * 8 + e];
#pragma unroll
        for (int i = 0; i < 4; ++i) {
            const int r = srow + 32 * i;
            const uint4 a = *(const uint4*)(WSg + (size_t)r * 128 + kt * 64 + sc * 8);
            *(uint4*)(lds + kt * 32768 + swz<128>(r, sc)) = a;
            const uint4 bv = *(const uint4*)(GVT + (size_t)r * 128 + kt * 64 + sc * 8);
            const float gn = gain[r];
            const unsigned w[4] = {bv.x, bv.y, bv.z, bv.w};
            unsigned ow[4];
#pragma unroll
            for (int e = 0; e < 4; ++e) ow[e] = pk2(bf2f(w[e] & 0xffffu) * rs[2 * e] * gn, bf2f(w[e] >> 16) * rs[2 * e + 1] * gn);
            *(uint4*)(lds + kt * 32768 + 16384 + swz<128>(r, sc)) = make_uint4(ow[0], ow[1], ow[2], ow[3]);
        }
    }
    __syncthreads();
    f32x4 acc[4][4]; zero_acc<4>(acc);
    KT_OFFS(4)
    compute_ktile<4>(lds, lds + 16384, acc, aoff0, aoff1, boff0, boff1);
    compute_ktile<4>(lds + 32768, lds + 32768 + 16384, acc, aoff0, aoff1, boff0, boff1);
    const float* bs = IN(p, 13) + l * 512 + g * 128;
    bf16_t* GU = (bf16_t*)(wsb + O_GU);
#pragma unroll
    for (int mt = 0; mt < 4; ++mt) {
        const int pr = wr * 64 + mt * 16 + l15;
        const float bias = bs[pr];
#pragma unroll
        for (int nt = 0; nt < 4; ++nt) {
            bf16_t* up = GU + (size_t)(row0 + pr) * 512 + g * 128 + wc * 64 + nt * 16 + quad * 4;
            const f32x4 u = unpk4(*(const uint2*)up);
            const uint2 w = pk4(u * (acc[mt][nt] + bias)); if (!dry) *(uint2*)up = w; else asm volatile("" :: "v"(w.x), "v"(w.y));
        }
    }
}

template <int DIR, int PASS>
DEVI void lru_dir(const Params& p, int l, int b, int ck, int h, char* lds, bool dry) {
    LANE_VARS
    const int tid = TIDX();
    const bf16_t* W = (const bf16_t*)(WS(p) + O_W);
    float* sA = (float*)(lds + 8192); float* sB = (float*)(lds + 24576);
    float2* pagg = (float2*)(lds + 40960); float* carry = (float*)(lds + 43008); float* sHF = (float*)(lds + 45056);
    bf16x8 xf[2];
#pragma unroll
    for (int ks = 0; ks < 2; ++ks) xf[ks] = *(const bf16x8*)(lds + swz<128>(wave * 16 + l15, ks * 4 + quad));
    f32x4 aA[4], aI[4];
    const bf16_t* wa = W + W_LWA + (size_t)(DIR * 8 + h) * 4096;
    const bf16_t* wi = W + W_LWI + (size_t)(DIR * 8 + h) * 4096;
#pragma unroll
    for (int nt = 0; nt < 4; ++nt) {
        aA[nt] = (f32x4){0.f, 0.f, 0.f, 0.f}; aI[nt] = (f32x4){0.f, 0.f, 0.f, 0.f};
#pragma unroll
        for (int ks = 0; ks < 2; ++ks) {
            const bf16x8 fa = *(const bf16x8*)(wa + (nt * 16 + l15) * 64 + ks * 32 + quad * 8);
            const bf16x8 fi = *(const bf16x8*)(wi + (nt * 16 + l15) * 64 + ks * 32 + quad * 8);
            aA[nt] = __builtin_amdgcn_mfma_f32_16x16x32_bf16(fa, xf[ks], aA[nt], 0, 0, 0);
            aI[nt] = __builtin_amdgcn_mfma_f32_16x16x32_bf16(fi, xf[ks], aI[nt], 0, 0, 0);
        }
    }
    const int t = wave * 16 + l15;
#pragma unroll
    for (int nt = 0; nt < 4; ++nt) {
        const int chb = nt * 16 + quad * 4, gch = (l * 2 + DIR) * 512 + h * 64 + chb;
        const f32x4 ba4 = *(const f32x4*)(IN(p, 18) + gch), bi4 = *(const f32x4*)(IN(p, 20) + gch), sp4 = *(const f32x4*)((const float*)(WS(p) + O_SP) + DIR * 512 + h * 64 + chb);
        const f32x4 x4 = unpk4(*(const uint2*)(lds + swz<128>(t, nt * 2 + (quad >> 1)) + (quad & 1) * 8));
        f32x4 av, bv;
#pragma unroll
        for (int j = 0; j < 4; ++j) {
            const float r = sigm(aA[nt][j] + ba4[j]), ii = sigm(aI[nt][j] + bi4[j]);
            const float la = -8.f * r * sp4[j];
            const float a = __expf(la);
            av[j] = a;
            const float x = 2.f * la;
            const float ser = -x * (1.f + x * (0.5f + x * (0.16666667f + x * (0.041666668f + x * (0.008333334f + x * 0.0013888889f)))));
            const float om = (x > -0.25f) ? ser : (1.f - a * a);
            bv[j] = __builtin_amdgcn_sqrtf(om) * ii * x4[j];
        }
        *(f32x4*)(sA + t * 64 + chb) = av; *(f32x4*)(sB + t * 64 + chb) = bv;
    }
    __syncthreads();
    const int ch = tid & 63, part = wave;
    float A = 1.f, B = 0.f;
#pragma unroll
    for (int k = 0; k < 16; ++k) { const int tt = part * 16 + (DIR == 0 ? k : 15 - k); const float a = sA[tt * 64 + ch], bb = sB[tt * 64 + ch]; B = a * B + bb; A *= a; }
    pagg[part * 64 + ch] = make_float2(A, B);
    __syncthreads();
    if (PASS == 1) {
        if (part == 0) {
            float At = 1.f, Bt = 0.f;
#pragma unroll
            for (int q = 0; q < 4; ++q) { const int pp = DIR == 0 ? q : 3 - q; const float2 ab = pagg[pp * 64 + ch]; Bt = ab.x * Bt + ab.y; At *= ab.x; }
            ((float2*)(WS(p) + O_AGG))[((size_t)((b * 2 + DIR) * 64 + ck)) * 512 + h * 64 + ch] = make_float2(At, Bt);
        }
    } else {
        float hin = carry[DIR * 64 + ch];
#pragma unroll
        for (int q = 0; q < 4; ++q) { const int pp = DIR == 0 ? q : 3 - q; const bool before = DIR == 0 ? (pp < part) : (pp > part);
            if (before) { const float2 ab = pagg[pp * 64 + ch]; hin = ab.x * hin + ab.y; } }
        bf16_t* GY = (bf16_t*)(WS(p) + O_GY);
#pragma unroll
        for (int k = 0; k < 16; ++k) {
            const int tt = part * 16 + (DIR == 0 ? k : 15 - k);
            hin = sA[tt * 64 + ch] * hin + sB[tt * 64 + ch];
            if (DIR == 0) sHF[tt * 64 + ch] = hin;
            else { bf16_t* gp = GY + (size_t)(b * 4096 + ck * 64 + tt) * 512 + h * 64 + ch; const unsigned w = f2bf((sHF[tt * 64 + ch] + hin) * bf2f(*gp)); if (!dry) *gp = (bf16_t)w; else asm volatile("" :: "v"(w)); }
        }
    }
    __syncthreads();
}
template <int PASS>
DEVI void lru_items(const Params& p, int l, int item0, int nitem, int stride, char* lds, bool dry) {
    const int tid = TIDX(), h = item0 & 7;
    const int c8 = tid & 7, chg = h * 64 + c8 * 8;
    float w[4][8], cb[8];
    {
        const f32x4 c0 = *(const f32x4*)(IN(p, 16) + l * 512 + chg), c1 = *(const f32x4*)(IN(p, 16) + l * 512 + chg + 4);
#pragma unroll
        for (int e = 0; e < 4; ++e) { cb[e] = c0[e]; cb[4 + e] = c1[e]; }
#pragma unroll
        for (int j = 0; j < 4; ++j) {
            const f32x4 w0 = *(const f32x4*)(IN(p, 15) + (l * 4 + j) * 512 + chg), w1 = *(const f32x4*)(IN(p, 15) + (l * 4 + j) * 512 + chg + 4);
#pragma unroll
            for (int e = 0; e < 4; ++e) { w[j][e] = w0[e]; w[j][4 + e] = w1[e]; }
        }
    }
    for (int ii = 0; ii < nitem; ++ii) {
    const int item = item0 + ii * stride, ck = (item >> 3) & 63, b = item >> 9;
    __syncthreads();
    {
        const bf16_t* LX = (const bf16_t*)(WS(p) + O_LX);
#pragma unroll
        for (int it = 0; it < 2; ++it) {
            const int t = (tid >> 3) + 32 * it, s = ck * 64 + t;
            float a8[8];
#pragma unroll
            for (int e = 0; e < 8; ++e) a8[e] = cb[e];
#pragma unroll
            for (int j = 0; j < 4; ++j) {
                const int s2 = s + j - 2;
                if (s2 >= 0 && s2 < 4096) {
                    const uint4 raw = *(const uint4*)(LX + (size_t)(b * 4096 + s2) * 512 + chg);
                    const unsigned rw[4] = {raw.x, raw.y, raw.z, raw.w};
#pragma unroll
                    for (int e = 0; e < 4; ++e) { a8[2 * e] += w[j][2 * e] * bf2f(rw[e] & 0xffffu); a8[2 * e + 1] += w[j][2 * e + 1] * bf2f(rw[e] >> 16); }
                }
            }
            *(uint4*)(lds + swz<128>(t, c8)) = make_uint4(pk2(a8[0], a8[1]), pk2(a8[2], a8[3]), pk2(a8[4], a8[5]), pk2(a8[6], a8[7]));
        }
    }
    if (PASS == 3) {
        float2* stg = (float2*)(lds + 8192);
        const int ch = tid & 63;
        const float2* aggb = (const float2*)(WS(p) + O_AGG) + h * 64 + ch;
#pragma unroll
        for (int i = 0; i < 16; ++i) {
            const int c2 = (tid >> 6) + 4 * i;
            if (c2 != ck) { const int dir = c2 < ck ? 0 : 1; stg[c2 * 64 + ch] = aggb[((size_t)(b * 2 + dir) * 64 + c2) * 512]; }
        }
        __syncthreads();
        if (tid < 128) {
            const int dir = tid >> 6;
            float hc = 0.f;
            if (dir == 0) { for (int c2 = 0; c2 < ck; ++c2) { const float2 ab = stg[c2 * 64 + ch]; hc = ab.x * hc + ab.y; } }
            else { for (int c2 = 63; c2 > ck; --c2) { const float2 ab = stg[c2 * 64 + ch]; hc = ab.x * hc + ab.y; } }
            ((float*)(lds + 43008))[dir * 64 + ch] = hc;
        }
    }
    __syncthreads();
    lru_dir<0, PASS>(p, l, b, ck, h, lds, dry);
    lru_dir<1, PASS>(p, l, b, ck, h, lds, dry);
    }
}

DEVI void tjob(const float* __restrict__ src, bf16_t* __restrict__ dst, int K, int N, const float* gain, int perm, char* lds, int& toff, int vbid, int VG) {
    float* lf = (float*)lds;
    const int tid = TIDX(), tilesK = K >> 6, ntiles = tilesK * (N >> 6);
    const int start = (vbid - (toff % VG) + VG) % VG;
    toff += ntiles;
    const int iters = (ntiles + VG - 1) / VG;
    float v[16];
#define TJ_LOAD(t_) { const int tk_ = (t_) % tilesK, tn_ = (t_) / tilesK; const int np = tn_ * 64 + (tid & 15) * 4; int scol = np; \
        if (perm) { const int g = np >> 5, w = np & 31; scol = (w < 16) ? (g * 16 + w) : (2816 + g * 16 + w - 16); } \
        _Pragma("unroll") for (int i = 0; i < 4; ++i) { const int k = tk_ * 64 + (tid >> 4) + 16 * i; f32x4 x = *(const f32x4*)(src + (size_t)k * N + scol); if (gain) x *= gain[k]; \
            v[4 * i] = x[0]; v[4 * i + 1] = x[1]; v[4 * i + 2] = x[2]; v[4 * i + 3] = x[3]; } }
    if (start < ntiles) TJ_LOAD(start)
    for (int it = 0; it < iters; ++it) {
        const int t = start + it * VG;
        const bool act = t < ntiles;
        const int tk = t % tilesK, tn = t / tilesK;
        __syncthreads();
        if (act) {
#pragma unroll
            for (int i = 0; i < 4; ++i)
#pragma unroll
                for (int e = 0; e < 4; ++e) lf[((tid >> 4) + 16 * i) * 65 + (tid & 15) * 4 + e] = v[4 * i + e];
        }
        if (t + VG < ntiles) TJ_LOAD(t + VG)
        __syncthreads();
        if (act) {
            const int nl = tid >> 2, kb = (tid & 3) * 16;
            unsigned w[8];
#pragma unroll
            for (int e = 0; e < 8; ++e) w[e] = pk2(lf[(kb + 2 * e) * 65 + nl], lf[(kb + 2 * e + 1) * 65 + nl]);
            bf16_t* dp = dst + (size_t)(tn * 64 + nl) * K + tk * 64 + kb;
            *(uint4*)dp = make_uint4(w[0], w[1], w[2], w[3]);
            *(uint4*)(dp + 8) = make_uint4(w[4], w[5], w[6], w[7]);
        }
    }
#undef TJ_LOAD
}
DEVI void convert_weights(const Params& p, int l, char* lds, int vbid, int VG) {
    asm volatile("" : "+s"(VG));
    bf16_t* W = (bf16_t*)(WS(p) + O_W);
    int toff = 0;
    tjob(IN(p, 3) + (size_t)l * 1024 * 5632, W + W_1IN, 1024, 5632, IN(p, 2) + l * 1024, 1, lds, toff, vbid, VG);
    tjob(IN(p, 4) + (size_t)l * 2816 * 1024, W + W_1OUT, 2816, 1024, nullptr, 0, lds, toff, vbid, VG);
    tjob(IN(p, 6) + (size_t)l * 1024 * 5888, W + W_MIX, 1024, 5888, IN(p, 5) + l * 1024, 0, lds, toff, vbid, VG);
    tjob(IN(p, 10) + (size_t)l * 512 * 1024, W + W_AU, 512, 1024, nullptr, 0, lds, toff, vbid, VG);
    tjob(IN(p, 14) + (size_t)l * 512 * 1024, W + W_GU, 512, 1024, nullptr, 0, lds, toff, vbid, VG);
    tjob(IN(p, 22) + (size_t)l * 512 * 1024, W + W_LU, 512, 1024, nullptr, 0, lds, toff, vbid, VG);
    tjob(IN(p, 23) + (size_t)l * 1024 * 1024, W + W_MO, 1024, 1024, nullptr, 0, lds, toff, vbid, VG);
    tjob(IN(p, 26) + (size_t)l * 1024 * 1024, W + W_Q, 1024, 1024, IN(p, 24) + l * 1024, 0, lds, toff, vbid, VG);
    tjob(IN(p, 27) + (size_t)l * 1024 * 2048, W + W_KV, 1024, 2048, nullptr, 0, lds, toff, vbid, VG);
    tjob(IN(p, 28) + (size_t)l * 1024 * 1024, W + W_O, 1024, 1024, nullptr, 0, lds, toff, vbid, VG);
    tjob(IN(p, 30) + (size_t)l * 1024 * 5632, W + W_2IN, 1024, 5632, IN(p, 29) + l * 1024, 1, lds, toff, vbid, VG);
    tjob(IN(p, 31) + (size_t)l * 2816 * 1024, W + W_2OUT, 2816, 1024, nullptr, 0, lds, toff, vbid, VG);
    const int gt = vbid * 256 + TIDX(), gs = VG * 256;
    for (int i = gt; i < 65536; i += gs) {
        const int mat = i >> 12, o = (i >> 6) & 63, ii = i & 63;
        W[W_LWA + i] = (bf16_t)f2bf(IN(p, 17)[(size_t)l * 65536 + mat * 4096 + ii * 64 + o]);
        W[W_LWI + i] = (bf16_t)f2bf(IN(p, 19)[(size_t)l * 65536 + mat * 4096 + ii * 64 + o]);
        W[W_GWS + i] = (bf16_t)f2bf(IN(p, 12)[(size_t)l * 65536 + i]);
    }
    for (int i = gt; i < 1024; i += gs) ((float*)(WS(p) + O_SP))[i] = log1pf(expf(-IN(p, 21)[l * 1024 + i]));
    bf16_t* MEMN = (bf16_t*)(WS(p) + O_MEMN);
    const int lane = TIDX() & 63, gw = vbid * 4 + (TIDX() >> 6), nw = VG * 4;
    for (int row = gw; row < 1024; row += nw) {
        f32x4 v[4]; float s = 0.f;
#pragma unroll
        for (int i = 0; i < 4; ++i) { v[i] = *(const f32x4*)(IN(p, 1) + (size_t)row * 1024 + i * 256 + lane * 4); s += v[i][0] * v[i][0] + v[i][1] * v[i][1] + v[i][2] * v[i][2] + v[i][3] * v[i][3]; }
        s = wave_sum(s);
        const float rstd = rsqrtf(s * (1.f / 1024.f) + EPS);
#pragma unroll
        for (int i = 0; i < 4; ++i) { const f32x4 g = *(const f32x4*)(IN(p, 25) + l * 1024 + i * 256 + lane * 4); *(uint2*)(MEMN + (size_t)row * 1024 + i * 256 + lane * 4) = pk4(v[i] * rstd * g); }
    }
}

DEVI void run_phase(const Params& p, int ph, char* lds_all, bool dry) {
    unsigned char* ws = WS(p);
    bf16_t* W = (bf16_t*)(ws + O_W);
    bf16_t* XB = (bf16_t*)(ws + O_XB);
    float* X = p.out;
    const int RG = gridDim.x, rbid = blockIdx.x;
    const int vb = __builtin_amdgcn_readfirstlane(TID512() >> 8);
    const int G = RG * 2, bid = rbid * 2 + vb, tid = TIDX(), lane = tid & 63;
    char* lds = lds_all + vb * 65536;
    if (ph == 0) {
        convert_weights(p, 0, lds, bid, G);
        const int gw = bid * 4 + (tid >> 6), nw = G * 4;
        float* ss0 = SSP(p, 0);
        for (int row = gw; row < M; row += nw) {
            float s = 0.f;
#pragma unroll
            for (int i = 0; i < 4; ++i) {
                const size_t off = (size_t)row * 1024 + i * 256 + lane * 4;
                const f32x4 v = *(const f32x4*)(IN(p, 0) + off);
                *(f32x4*)(X + off) = v; *(uint2*)(XB + off) = pk4(v);
                s += v[0] * v[0] + v[1] * v[1] + v[2] * v[2] + v[3] * v[3];
            }
            s = wave_sum(s);
            if (lane < 16) ss0[(size_t)lane * M + row] = (lane == 0) ? s : 0.f;
        }
        if (bid == 0) for (int i = tid; i < 3456; i += 256) __hip_atomic_store((unsigned*)(ws + O_BAR) + i, 0u, __ATOMIC_RELAXED, __HIP_MEMORY_SCOPE_AGENT);
        if (bid == 0) {
            float* cosT = (float*)(ws + O_ROPE); float* sinT = cosT + 1024;
            for (int i = tid; i < 1024; i += 256) {
                const int pos = i >> 4, f = i & 15;
                const float inv = powf(10000.f, -(float)f / 16.f);
                const float ang = (float)pos * inv;
                cosT[i] = cosf(ang); sinT[i] = sinf(ang);
            }
        }
        return;
    }
    const int l = (ph - 1) / 13, q = (ph - 1) % 13;
    switch (q) {
    case 0: case 10: {
        const bf16_t* Bw = W + (q == 0 ? W_1IN : W_2IN);
        const float* ss = SSP(p, l * 5 + (q == 0 ? 0 : 3));
        const int nt1 = 64 * 22, ntot = nt1 + (q == 0 ? 32 : 0);
        int rs_mt = -1;
        for (int t = rbid; t < ntot; t += RG) {
            f32x4 acc[8][4]; zero_acc8<4>(acc);
            int mt, nt; const bf16_t* cA; const bf16_t* cB; const bf16_t* nA = nullptr; const bf16_t* nB = nullptr;
            if (t < nt1) { tile_decode8(t, 22, mt, nt); cA = XB + (size_t)mt * 256 * DM; cB = Bw + (size_t)nt * 256 * DM; }
            else { const int t2 = t - nt1; mt = t2 & 3; nt = t2 >> 2; cA = (const bf16_t*)(ws + O_MEMN) + (size_t)mt * 256 * DM; cB = W + W_KV + (size_t)nt * 256 * DM; }
            const int tn = t + RG;
            if (tn < ntot) {
                int m2, n2;
                if (tn < nt1) { tile_decode8(tn, 22, m2, n2); nA = XB + (size_t)m2 * 256 * DM; nB = Bw + (size_t)n2 * 256 * DM; }
                else { const int t2 = tn - nt1; m2 = t2 & 3; n2 = t2 >> 2; nA = (const bf16_t*)(ws + O_MEMN) + (size_t)m2 * 256 * DM; nB = W + W_KV + (size_t)n2 * 256 * DM; }
            }
            if (t < nt1 && mt != rs_mt) { stage_rstd(ss, mt * 256, lds_all); rs_mt = mt; }
            gemm_kloop8<4>(cA, DM, cB, DM, DM, lds_all, acc, t == rbid, nA, nB);
            if (t < nt1) epi_swiglu(acc, mt * 256, nt * 256, (const float*)(lds_all + 131072 + 2048), (bf16_t*)(ws + O_H));
            else epi_kv(acc, mt * 256, nt * 256, (bf16_t*)(ws + O_KX), (bf16_t*)(ws + O_VXT));
        }
    } break;
    case 1: case 11: {
        const bf16_t* Bw = W + (q == 1 ? W_1OUT : W_2OUT);
        float* sso = SSP(p, q == 1 ? (l * 5 + 1) : ((l + 1) * 5));
        for (int t = rbid; t < 64 * 4; t += RG) {
            int mt, nt; tile_decode8(t, 4, mt, nt);
            f32x4 acc[8][4]; zero_acc8<4>(acc);
            gemm_kloop8<4>((const bf16_t*)(ws + O_H) + (size_t)mt * 256 * FF, FF, Bw + (size_t)nt * 256 * FF, FF, FF, lds_all, acc, true, nullptr, nullptr);
            epi_resid(acc, mt * 256, nt * 256, X, XB, sso, 0.5f, dry);
        }
    } break;
    case 2: {
        int rs_mt = -1;
        for (int t = rbid; t < 64 * 23; t += RG) {
            int mt, nt; tile_decode8(t, 23, mt, nt);
            f32x4 acc[8][4]; zero_acc8<4>(acc);
            const bf16_t* nA = nullptr; const bf16_t* nB = nullptr;
            if (t + RG < 64 * 23) { int m2, n2; tile_decode8(t + RG, 23, m2, n2); nA = XB + (size_t)m2 * 256 * DM; nB = W + W_MIX + (size_t)n2 * 256 * DM; }
            if (mt != rs_mt) { stage_rstd(SSP(p, l * 5 + 1), mt * 256, lds_all); rs_mt = mt; }
            gemm_kloop8<4>(XB + (size_t)mt * 256 * DM, DM, W + W_MIX + (size_t)nt * 256 * DM, DM, DM, lds_all, acc, t == rbid, nA, nB);
            epi_mixin(acc, mt * 256, nt * 256, p, l, (const float*)(lds_all + 131072 + 2048));
        }
    } break;
    case 3: {
        int t = bid;
        for (; t < 512; t += G) gmlp_item(p, l, t, lds, lds_all + 131072 + 3072 + vb * 512, dry);
        lru_items<1>(p, l, t - 512, (2560 - t + G - 1) / G, G, lds, dry);
    } break;
    case 4: {
        float gq = fabsf(IN(p, 8)[l * 64 + lane]), gk = fabsf(IN(p, 9)[l * 64 + lane]);
#pragma unroll
        for (int o2 = 32; o2 > 0; o2 >>= 1) { gq = fmaxf(gq, __shfl_xor(gq, o2)); gk = fmaxf(gk, __shfl_xor(gk, o2)); }
        const float Bq = 8.f * gq * gk * 1.02f;
        const bool bounded = __builtin_amdgcn_readfirstlane(Bq <= 40.f ? 1 : 0) != 0;
        const float mfix = Bq * 1.4426950408889634f;
        int t = bid;
        for (; t < 1024; t += G) {
            {
                const int bk = t & 7, b = bk >> 1, kvh = bk & 1, g = (t >> 3) & 3, qb = t >> 5, head = kvh * 4 + g;
                bf16_t* Qp = (bf16_t*)(ws + O_Q) + (size_t)(b * 4096 + qb * 128) * 512 + head * 64;
                const bf16_t* Kp = (const bf16_t*)(ws + O_KB) + (size_t)(b * 4096) * 128 + kvh * 64;
                const bf16_t* Vp = (const bf16_t*)(ws + O_VT) + (size_t)((b * 2 + kvh) * 64) * 4096;
                __syncthreads();
                if (bounded) attn_item<64, 64, 2, false, true>(Qp, 512, Kp, 128, Vp, 4096, Qp, 512, 4096, 0.125f * 1.4426950408889634f, mfix, lds, dry);
                else attn_item<64, 64, 2, true, true>(Qp, 512, Kp, 128, Vp, 4096, Qp, 512, 4096, 0.125f * 1.4426950408889634f, 0.f, lds, dry);
            }
        }
        lru_items<3>(p, l, t - 1024, (3072 - t + G - 1) / G, G, lds, dry);
    } break;
    case 5: {
        const bf16_t* GT = (const bf16_t*)(ws + O_GATES);
        bf16_t* MG = (bf16_t*)(ws + O_MERGED);
        for (int t = rbid; t < 64 * 8; t += RG) {
            int mt, nt; tile_decode8(t, 8, mt, nt);
            LANE512
            f32x4 tot[8][2], ac2[8][2]; zero_acc8<2>(tot);
#pragma unroll 1
            for (int br = 0; br < 3; ++br) {
                const bf16_t* Ab = (const bf16_t*)(ws + (br == 0 ? O_Q : (br == 1 ? O_GU : O_GY)));
                zero_acc8<2>(ac2);
                const bf16_t* nA = nullptr; const bf16_t* nB = nullptr;
                if (br < 2) { nA = (const bf16_t*)(ws + (br == 0 ? O_GU : O_GY)) + (size_t)mt * 256 * 512; nB = W + W_AU + (size_t)(br + 1) * 524288 + (size_t)nt * 128 * 512; }
                else if (t + RG < 64 * 8) { int m2, n2; tile_decode8(t + RG, 8, m2, n2); nA = (const bf16_t*)(ws + O_Q) + (size_t)m2 * 256 * 512; nB = W + W_AU + (size_t)n2 * 128 * 512; }
                gemm_kloop8<2>(Ab + (size_t)mt * 256 * 512, 512, W + W_AU + (size_t)br * 524288 + (size_t)nt * 128 * 512, 512, 512, lds_all, ac2, t == rbid && br == 0, nA, nB);
#pragma unroll
                for (int a = 0; a < 8; ++a) {
                    const int row = mt * 256 + wr * 128 + a * 16 + l15;
#pragma unroll
                    for (int b2 = 0; b2 < 2; ++b2) {
                        const f32x4 g4 = unpk4(*(const uint2*)(GT + (size_t)row * 3072 + br * 1024 + nt * 128 + wc * 32 + b2 * 16 + quad * 4));
                        tot[a][b2] += g4 * ac2[a][b2];
                    }
                }
            }
#pragma unroll
            for (int a = 0; a < 8; ++a) {
                const int row = mt * 256 + wr * 128 + a * 16 + l15;
#pragma unroll
                for (int b2 = 0; b2 < 2; ++b2) *(uint2*)(MG + (size_t)row * DM + nt * 128 + wc * 32 + b2 * 16 + quad * 4) = pk4(tot[a][b2]);
            }
        }
    } break;
    case 6: case 9: {
        const bf16_t* Ab = (const bf16_t*)(ws + (q == 6 ? O_MERGED : O_OX));
        const bf16_t* Bw = W + (q == 6 ? W_MO : W_O);
        float* sso = SSP(p, l * 5 + (q == 6 ? 2 : 3));
        for (int t = rbid; t < 64 * 4; t += RG) {
            int mt, nt; tile_decode8(t, 4, mt, nt);
            f32x4 acc[8][4]; zero_acc8<4>(acc);
            gemm_kloop8<4>(Ab + (size_t)mt * 256 * DM, DM, Bw + (size_t)nt * 256 * DM, DM, DM, lds_all, acc, true, nullptr, nullptr);
            epi_resid(acc, mt * 256, nt * 256, X, XB, sso, 1.0f, dry);
        }
    } break;
    case 7: {
        const float* ss = SSP(p, l * 5 + 2);
        for (int t = rbid; t < 64 * 4; t += RG) {
            int mt, nt; tile_decode8(t, 4, mt, nt);
            f32x4 acc[8][4]; zero_acc8<4>(acc);
            stage_rstd(ss, mt * 256, lds_all);
            gemm_kloop8<4>(XB + (size_t)mt * 256 * DM, DM, W + W_Q + (size_t)nt * 256 * DM, DM, DM, lds_all, acc, true, nullptr, nullptr);
            epi_qx(acc, mt * 256, nt * 256, (const float*)(lds_all + 131072 + 2048), (bf16_t*)(ws + O_QX));
        }
    } break;
    case 8: {
        for (int t = bid; t < 1024; t += G) {
            const int bh = t & 15, b = bh >> 2, h = bh & 3, qt = t >> 4;
            const bf16_t* Qp = (const bf16_t*)(ws + O_QX) + (size_t)(b * 4096 + qt * 64) * 1024 + h * 256;
            const bf16_t* Kp = (const bf16_t*)(ws + O_KX) + (size_t)(b * 256) * 1024 + h * 256;
            const bf16_t* Vp = (const bf16_t*)(ws + O_VXT) + (size_t)((b * 4 + h) * 256) * 256;
            bf16_t* Op = (bf16_t*)(ws + O_OX) + (size_t)(b * 4096 + qt * 64) * 1024 + h * 256;
            __syncthreads();
            attn_item<256, 32, 1, true>(Qp, 1024, Kp, 1024, Vp, 256, Op, 1024, 256, 0.0625f * 1.4426950408889634f, 0.f, lds, dry);
        }
    } break;
    case 12: {
        if (l == 0) convert_weights(p, 1, lds, bid, G);
        else {
            const int gw = bid * 4 + (tid >> 6), nw = G * 4;
            const float* ss = SSP(p, 10);
            for (int row = gw; row < M; row += nw) {
                const float rstd = rsqrtf(ss_sum<16>(ss, row) * (1.f / 1024.f) + EPS);
#pragma unroll
                for (int i = 0; i < 4; ++i) {
                    const size_t off = (size_t)row * 1024 + i * 256 + lane * 4;
                    const f32x4 g = *(const f32x4*)(IN(p, 32) + i * 256 + lane * 4);
                    const f32x4 y = *(const f32x4*)(X + off) * rstd * g; if (!dry) *(f32x4*)(X + off) = y; else asm volatile("" :: "v"(y[0]), "v"(y[1]), "v"(y[2]), "v"(y[3]));
                }
            }
        }
    } break;
    }
}


#define XB_TMO      128
#define XB_XCNT(j)  (256  + 64 * (j))
#define XB_XSUB(j)  (1280 + 64 * (j))
#define XB_XGEN(j)  (2304 + 64 * (j))
#define XB_TOP      3328
#define XB_TOPGEN   3392
#define XCD_BAR_WORDS 3456
#define XB_SPIN_CAP (1u << 22)
DEVI unsigned xb_ld(unsigned* p)              { return __hip_atomic_load(p, __ATOMIC_RELAXED, __HIP_MEMORY_SCOPE_AGENT); }
DEVI unsigned xb_add(unsigned* p, unsigned v) { return __hip_atomic_fetch_add(p, v, __ATOMIC_RELAXED, __HIP_MEMORY_SCOPE_AGENT); }
DEVI unsigned xb_xcc_id() { return (unsigned)__builtin_amdgcn_s_getreg((3 << 11) | 20) & 0xFu; }
#define XB_SPIN(cond, bar) do { unsigned _sp = 0; while (cond) { __builtin_amdgcn_s_sleep(1); \
    if ((++_sp & 255u) == 0u) { if (xb_ld(&(bar)[XB_TMO])) break; if (_sp > XB_SPIN_CAP) { atomicAdd(&(bar)[XB_TMO], 1u); break; } } } } while (0)
DEVI void xcd_barrier_complete(unsigned* bar, unsigned x, unsigned& nloc, unsigned& nx) {
    const unsigned G = gridDim.x;
    unsigned sum, cnt, mine, sp = 0u;
    for (;;) {
        sum = 0u; cnt = 0u; mine = 0u;
#pragma unroll
        for (unsigned j = 0; j < 16; ++j) { const unsigned c = xb_ld(&bar[XB_XCNT(j)]); sum += c; cnt += (c > 0u) ? 1u : 0u; mine = (j == x) ? c : mine; }
        if (sum == G) break;
        __builtin_amdgcn_s_sleep(1);
        if ((++sp & 255u) == 0u) { if (xb_ld(&bar[XB_TMO])) break; if (sp > XB_SPIN_CAP) { atomicAdd(&bar[XB_TMO], 1u); break; } }
    }
    nloc = mine > 0u ? mine : 1u; nx = cnt > 0u ? cnt : 1u;
}
DEVI void xcd_barrier(unsigned* bar, LDS_AS volatile unsigned* st) {
    asm volatile("s_waitcnt vmcnt(0)" ::: "memory");
    __syncthreads();
    if (threadIdx.x == 0) {
        __builtin_amdgcn_s_waitcnt(0);
        const unsigned x = xb_xcc_id();
        unsigned nloc = st[0], nx = st[1];
        if (nloc == 0u) { xcd_barrier_complete(bar, x, nloc, nx); st[0] = nloc; st[1] = nx; }
        const unsigned old = xb_add(&bar[XB_XSUB(x)], 1u);
        const unsigned gen = old / nloc;
        if (old + 1u == (gen + 1u) * nloc) {
            __builtin_amdgcn_fence(__ATOMIC_RELEASE, "agent");
            asm volatile("s_waitcnt vmcnt(0)" ::: "memory");
            const unsigned og = xb_add(&bar[XB_TOP], 1u);
            const unsigned tg = og / nx;
            if (og + 1u == (tg + 1u) * nx) xb_add(&bar[XB_TOPGEN], 1u);
            else XB_SPIN(xb_ld(&bar[XB_TOPGEN]) == tg, bar);
            __builtin_amdgcn_fence(__ATOMIC_ACQUIRE, "agent");
            xb_add(&bar[XB_XGEN(x)], 1u);
            asm volatile("s_waitcnt vmcnt(0)" ::: "memory");
        } else {
            XB_SPIN(xb_ld(&bar[XB_XGEN(x)]) == gen, bar);
            __builtin_amdgcn_fence(__ATOMIC_ACQUIRE, "agent");
            asm volatile("s_waitcnt vmcnt(0)" ::: "memory");
        }
    }
    __syncthreads();
}

__global__ void __launch_bounds__(512) mega(Params p) {
    __shared__ __attribute__((aligned(16))) char lds[131072 + 4096 + 64];
    cg::grid_group grid = cg::this_grid();
    if (threadIdx.x == 0) { LDS_AS volatile unsigned* bst = (LDS_AS volatile unsigned*)(lds + 131072 + 4096); bst[0] = 0u; bst[1] = 0u; }
    __syncthreads();
    for (int ph = p.lo; ph < p.hi; ++ph) {
#ifdef REP_MASK
        { const int qq = ph == 0 ? 13 : (ph - 1) % 13; if ((REP_MASK >> qq) & 1) { run_phase(p, ph, lds, true); asm volatile("s_waitcnt vmcnt(0)" ::: "memory"); __syncthreads(); } }
#endif
        run_phase(p, ph, lds, false);
        if (ph + 1 < p.hi) {
            if (ph == p.lo) {
                asm volatile("s_waitcnt vmcnt(0)" ::: "memory");
                __syncthreads();
                if (threadIdx.x < 64) { __builtin_amdgcn_fence(__ATOMIC_RELEASE, "agent"); asm volatile("s_waitcnt vmcnt(0)" ::: "memory"); }
                grid.sync();
                if (threadIdx.x < 64) { __builtin_amdgcn_fence(__ATOMIC_ACQUIRE, "agent"); asm volatile("s_waitcnt vmcnt(0)" ::: "memory"); }
                if (threadIdx.x == 0) (void)xb_add((unsigned*)(WS(p) + O_BAR) + XB_XCNT(xb_xcc_id()), 1u);
                __syncthreads();
            } else xcd_barrier((unsigned*)(WS(p) + O_BAR), (LDS_AS volatile unsigned*)(lds + 131072 + 4096));
        }
    }
}

extern "C" void kernel_launch(void* const* d_in, const int* in_sizes, int n_in, void* d_out, int out_size, void* d_ws, size_t ws_size, hipStream_t stream) {
    static int grid_blocks = 0;
    if (!grid_blocks) {
        int dev = 0, cus = 0, per_cu = 0;
        (void)hipGetDevice(&dev);
        (void)hipDeviceGetAttribute(&cus, hipDeviceAttributeMultiprocessorCount, dev);
        (void)hipOccupancyMaxActiveBlocksPerMultiprocessor(&per_cu, mega, 512, 0);
        if (per_cu < 1) fprintf(stderr, "kernel_launch: occupancy query says %d blocks/CU\n", per_cu);
        grid_blocks = cus;
        if (ws_size < O_END) fprintf(stderr, "kernel_launch: workspace too small: %zu < %zu\n", ws_size, (size_t)O_END);
    }
    Params p{};
    for (int i = 0; i < 33; ++i) p.in[i] = (const float*)d_in[i];
    p.out = (float*)d_out; p.ws = (unsigned char*)d_ws;
    p.lo = 0; p.hi = NPH;
    void* args[] = {&p};
    hipError_t e = hipLaunchCooperativeKernel((void*)mega, dim3(grid_blocks), dim3(512), args, 0, stream);
    if (e != hipSuccess) fprintf(stderr, "cooperative launch failed: %s (grid %d)\n", hipGetErrorString(e), grid_blocks);
}
```
